# Optimizing an MI355X kernel written in HIP

```python
import jax, jax.numpy as jnp
from jax import lax
import numpy as np

D_MODEL = 1024
BATCH = 8
SEQ = 2048
DEPTH = 1

CHUNK = 64
Q_BLOCK = 128
HEAD_DIM = 64
N_HEADS_SB = 8
N_HEADS_FOX = 8
WIDTH_SB = N_HEADS_SB * HEAD_DIM
WIDTH_FOX = N_HEADS_FOX * HEAD_DIM
IN_COLS = 3 * WIDTH_SB + 3 * WIDTH_FOX + N_HEADS_FOX
D_FF = 2816
RMS_EPS = 1e-6
ATTN_SCALE = HEAD_DIM ** -0.5
FORGET_BIAS_MEAN = 2.0

kernel_name = "macaron_stickbreak_forgetting_gated_block"


def rms_norm(x, g):
    xf = x.astype(jnp.float32)
    y = xf * lax.rsqrt(jnp.mean(xf * xf, axis=-1, keepdims=True) + RMS_EPS)
    return (y * g.astype(jnp.float32)).astype(x.dtype)


def swiglu(h, w_gate, w_up, w_down):
    return (jax.nn.silu(h @ w_gate) * (h @ w_up)) @ w_down


def split_heads(t, n_heads):
    b, s, _ = t.shape
    return t.reshape(b, s, n_heads, HEAD_DIM).transpose(0, 2, 1, 3)


def merge_heads(t):
    b, h, s, d = t.shape
    return t.transpose(0, 2, 1, 3).reshape(b, s, h * d)


def stick_breaking_attention(q, k, v):
    seq = q.shape[2]
    outs = []
    for i in range(seq // Q_BLOCK):
        q0 = i * Q_BLOCK
        k_end = q0 + Q_BLOCK
        z = jnp.einsum('bhqd,bhkd->bhqk', q[:, :, q0:k_end], k[:, :, :k_end]).astype(jnp.float32) * ATTN_SCALE
        t_pos = q0 + jnp.arange(Q_BLOCK)[:, None]
        s_pos = jnp.arange(k_end)[None, :]
        strict = s_pos < t_pos
        log_not_beta = jnp.where(strict, jax.nn.log_sigmoid(-z), 0.0)
        between = lax.cumsum(log_not_beta, axis=3, reverse=True) - log_not_beta
        weights = jnp.where(strict, jnp.exp(jax.nn.log_sigmoid(z) + between), 0.0)
        outs.append(jnp.einsum('bhqk,bhkd->bhqd', weights.astype(v.dtype), v[:, :, :k_end]))
    return jnp.concatenate(outs, axis=2)


def forgetting_attention(q, k, v, log_f_cum):
    seq = q.shape[2]
    outs = []
    for i in range(seq // Q_BLOCK):
        q0 = i * Q_BLOCK
        k_end = q0 + Q_BLOCK
        logits = jnp.einsum('bhqd,bhkd->bhqk', q[:, :, q0:k_end], k[:, :, :k_end]).astype(jnp.float32) * ATTN_SCALE
        logits = logits + log_f_cum[:, :, q0:k_end, None] - log_f_cum[:, :, None, :k_end]
        t_pos = q0 + jnp.arange(Q_BLOCK)[:, None]
        s_pos = jnp.arange(k_end)[None, :]
        logits = jnp.where(s_pos <= t_pos, logits, -jnp.inf)
        probs = jax.nn.softmax(logits, axis=-1)
        outs.append(jnp.einsum('bhqk,bhkd->bhqd', probs.astype(v.dtype), v[:, :, :k_end]))
    return jnp.concatenate(outs, axis=2)


def setup_inputs(seed: int = 0) -> dict:
    key = jax.random.key(seed)
    ks = jax.random.split(key, 20)
    f32 = jnp.float32

    def dense(k, fan_in, fan_out):
        return jax.random.normal(k, (DEPTH, fan_in, fan_out), f32) * fan_in ** -0.5

    def gain(k, shape):
        return 1.0 + 0.02 * jax.random.normal(k, shape, f32)

    return {
        'x': jax.random.normal(ks[0], (BATCH, SEQ, D_MODEL), f32),
        'norm_ffn1': gain(ks[1], (DEPTH, D_MODEL)),
        'w_ffn1_gate': dense(ks[2], D_MODEL, D_FF),
        'w_ffn1_up': dense(ks[3], D_MODEL, D_FF),
        'w_ffn1_down': dense(ks[4], D_FF, D_MODEL),
        'norm_mix': gain(ks[5], (DEPTH, D_MODEL)),
        'w_in': dense(ks[6], D_MODEL, IN_COLS),
        'b_forget': FORGET_BIAS_MEAN + 0.1 * jax.random.normal(ks[7], (DEPTH, N_HEADS_FOX), f32),
        'w_gate': dense(ks[8], D_MODEL, 2 * D_MODEL),
        'b_gate': 0.02 * jax.random.normal(ks[9], (DEPTH, 2 * D_MODEL), f32),
        'w_up_a': dense(ks[10], WIDTH_SB, D_MODEL),
        'w_up_b': dense(ks[11], WIDTH_FOX, D_MODEL),
        'w_out': dense(ks[12], D_MODEL, D_MODEL),
        'norm_ffn2': gain(ks[13], (DEPTH, D_MODEL)),
        'w_ffn2_gate': dense(ks[14], D_MODEL, D_FF),
        'w_ffn2_up': dense(ks[15], D_MODEL, D_FF),
        'w_ffn2_down': dense(ks[16], D_FF, D_MODEL),
        'norm_final': gain(ks[17], (D_MODEL,)),
    }


def reference(x, norm_ffn1, w_ffn1_gate, w_ffn1_up, w_ffn1_down, norm_mix, w_in, b_forget,
              w_gate, b_gate, w_up_a, w_up_b, w_out, norm_ffn2, w_ffn2_gate, w_ffn2_up,
              w_ffn2_down, norm_final):
    splits = np.cumsum([WIDTH_SB, WIDTH_SB, WIDTH_SB, WIDTH_FOX, WIDTH_FOX, WIDTH_FOX]).tolist()
    for l in range(DEPTH):
        x = x + 0.5 * swiglu(rms_norm(x, norm_ffn1[l]), w_ffn1_gate[l], w_ffn1_up[l], w_ffn1_down[l])

        h = rms_norm(x, norm_mix[l])
        proj = h @ w_in[l]
        q_a, k_a, v_a, q_b, k_b, v_b, f_logit = jnp.split(proj, splits, axis=-1)

        y_a = merge_heads(stick_breaking_attention(
            split_heads(q_a, N_HEADS_SB), split_heads(k_a, N_HEADS_SB), split_heads(v_a, N_HEADS_SB)))

        log_f = jax.nn.log_sigmoid((f_logit + b_forget[l]).astype(jnp.float32))
        log_f_cum = jnp.cumsum(log_f, axis=1).transpose(0, 2, 1)
        y_b = merge_heads(forgetting_attention(
            split_heads(q_b, N_HEADS_FOX), split_heads(k_b, N_HEADS_FOX), split_heads(v_b, N_HEADS_FOX),
            log_f_cum))

        gates = jax.nn.sigmoid(h @ w_gate[l] + b_gate[l])
        g_a, g_b = jnp.split(gates, 2, axis=-1)
        mixed = g_a * (y_a @ w_up_a[l]) + g_b * (y_b @ w_up_b[l])
        x = x + mixed @ w_out[l]

        x = x + 0.5 * swiglu(rms_norm(x, norm_ffn2[l]), w_ffn2_gate[l], w_ffn2_up[l], w_ffn2_down[l])
    return rms_norm(x, norm_final)
```

```cpp
#include <hip/hip_runtime.h>
#include <hip/hip_cooperative_groups.h>
#include <cstdio>
#include <cstdint>
#include <cmath>
namespace pg8 {
#define PG8_LAS __attribute__((address_space(3)))
typedef unsigned short bf16_t;
typedef short bf16x8 __attribute__((ext_vector_type(8)));
typedef float f32x4 __attribute__((ext_vector_type(4)));
typedef unsigned u32x4 __attribute__((ext_vector_type(4)));
constexpr int BM = 256, BK = 64, HALF = 128, HTB = HALF * BK * 2  , STAGE_BYTES = 8 * HTB, NXCD = 8, WGM = 8;

__host__ __device__ __forceinline__ int lds_byte(int r, int c) { const int st = (r >> 4) * 2 + (c >> 5), rr = r & 15, cc = c & 31, ob = rr * 64 + cc * 2; return st * 1024 + (ob ^ (((ob >> 9) & 1) << 5)); }
__host__ __device__ __forceinline__ void stage_rc(int b, int& R, int& C) { const int st = b / 1024, sb = b % 1024, swz = sb ^ (((sb >> 9) & 1) << 5); R = (st >> 1) * 16 + swz / 64; C = (st & 1) * 32 + (swz % 64) / 2; }
__host__ __device__ __forceinline__ int perm32(int rho) { const int n = rho >> 4, i = rho & 15; return 8 * (i >> 2) + 4 * n + (i & 3); }

struct Unit { int pm, pn; };
struct Gemm { const bf16_t* A; const bf16_t* Bt; int M, N, K, lda, grp_tiles, grp_cols; };

struct StaticOrder {
    int nM, nN, nwg, G, c;
    __host__ __device__ void init(int M, int N, int G_, int c_) { nM = M / BM; nN = N / BM; nwg = nM * nN; G = G_; c = c_; }
    __host__ __device__ bool next(int i, Unit& u) const {
        const long L = (long)i * G + c; if (L >= nwg) return false;
        int wgid = (int)L; { const int q = nwg / NXCD, r = nwg % NXCD, xcd = wgid % NXCD, off = wgid / NXCD; wgid = (xcd < r ? xcd * (q + 1) : r * (q + 1) + (xcd - r) * q) + off; }
        const int nig = WGM * nN, gid = wgid / nig, fm = gid * WGM, gsz = (nM - fm) < WGM ? (nM - fm) : WGM;
        u.pm = fm + ((wgid % nig) % gsz); u.pn = (wgid % nig) / gsz; return true;
    }
    __device__ __forceinline__ void a_ready(const Unit&) const {}
    __device__ __forceinline__ void done(const Unit&) const {}
};

typedef float f32x2_t __attribute__((ext_vector_type(2))); typedef __bf16 bf16x2_t __attribute__((ext_vector_type(2)));
__device__ __forceinline__ unsigned cvt_pk_bf16(float lo, float hi) { f32x2_t v = {lo, hi}; bf16x2_t b = __builtin_convertvector(v, bf16x2_t); return __builtin_bit_cast(unsigned, b); }
constexpr float LOG2E = 1.4426950408889634f;
__device__ __forceinline__ float sigmoid_f(float v) { return __builtin_amdgcn_rcpf(1.0f + __builtin_amdgcn_exp2f(-v * LOG2E)); }
__device__ __forceinline__ u32x4 pack8(const f32x4 a, const f32x4 b) { u32x4 w; w.x = cvt_pk_bf16(a[0], a[1]); w.y = cvt_pk_bf16(a[2], a[3]); w.z = cvt_pk_bf16(b[0], b[1]); w.w = cvt_pk_bf16(b[2], b[3]); return w; }

struct EpiSwiGLU {
    static constexpr bool PERM = true, AFTER_DRAIN = false;
    bf16_t* O; int ldc;
    __device__ __forceinline__ void operator()(const f32x4 (&acc)[2][2][4][2], const Unit& u, int wr, int wc, int fr, int fq) const {
        const int row0 = u.pm * BM + wr * 64 + fr, col0 = u.pn * HALF + wc * 32 + 8 * fq;
#pragma unroll
        for (int ai = 0; ai < 2; ++ai)
#pragma unroll
            for (int m = 0; m < 4; ++m) { bf16_t* rowp = O + (size_t)(row0 + ai * HALF + m * 16) * ldc + col0;
                f32x4 v[2];
#pragma unroll
                for (int n = 0; n < 2; ++n) { const f32x4 g = acc[ai][0][m][n], up = acc[ai][1][m][n];
#pragma unroll
                    for (int e = 0; e < 4; ++e) v[n][e] = g[e] * sigmoid_f(g[e]) * up[e]; }
                *(u32x4*)rowp = pack8(v[0], v[1]); }
    }
};
struct EpiResF32 {
    static constexpr bool PERM = false, AFTER_DRAIN = false;
    float* X; int ldc; float scale;
    __device__ __forceinline__ void operator()(const f32x4 (&acc)[2][2][4][2], const Unit& u, int wr, int wc, int fr, int fq) const {
        const int row0 = u.pm * BM + wr * 64 + fr, col0 = u.pn * BM + wc * 32 + 4 * fq;
#pragma unroll
        for (int ai = 0; ai < 2; ++ai)
#pragma unroll
            for (int m = 0; m < 4; ++m) { float* rowp = X + (size_t)(row0 + ai * HALF + m * 16) * ldc + col0;
#pragma unroll
                for (int bj = 0; bj < 2; ++bj)
#pragma unroll
                    for (int n = 0; n < 2; ++n) { f32x4* p = (f32x4*)(rowp + bj * HALF + n * 16); *p = *p + acc[ai][bj][m][n] * scale; } }
    }
};
struct EpiQKVG {
    static constexpr bool PERM = true, AFTER_DRAIN = false;
    bf16_t* QKV; bf16_t* G; const float* bgate; float c2;
    __device__ __forceinline__ void operator()(const f32x4 (&acc)[2][2][4][2], const Unit& u, int wr, int wc, int fr, int fq) const {
        const int row0 = u.pm * BM + wr * 64 + fr;
        if (u.pn < 12) {
            const float sc = (u.pn < 2 || (u.pn >= 6 && u.pn < 8)) ? c2 : 1.0f;
            const int col0 = u.pn * BM + wc * 32 + 8 * fq;
#pragma unroll
            for (int ai = 0; ai < 2; ++ai)
#pragma unroll
                for (int m = 0; m < 4; ++m) { bf16_t* rowp = QKV + (size_t)(row0 + ai * HALF + m * 16) * 3072 + col0;
#pragma unroll
                    for (int bj = 0; bj < 2; ++bj) *(u32x4*)(rowp + bj * HALF) = pack8(acc[ai][bj][m][0] * sc, acc[ai][bj][m][1] * sc); }
        } else {
            const int col0 = (u.pn - 12) * BM + wc * 32 + 8 * fq;
            f32x4 bv[2][2];
#pragma unroll
            for (int bj = 0; bj < 2; ++bj)
#pragma unroll
                for (int n = 0; n < 2; ++n) bv[bj][n] = *(const f32x4*)(bgate + col0 + bj * HALF + 4 * n);
#pragma unroll
            for (int ai = 0; ai < 2; ++ai)
#pragma unroll
                for (int m = 0; m < 4; ++m) { bf16_t* rowp = G + (size_t)(row0 + ai * HALF + m * 16) * 2048 + col0;
#pragma unroll
                    for (int bj = 0; bj < 2; ++bj) { f32x4 v[2];
#pragma unroll
                        for (int n = 0; n < 2; ++n) { const f32x4 t = acc[ai][bj][m][n] + bv[bj][n];
#pragma unroll
                            for (int e = 0; e < 4; ++e) v[n][e] = sigmoid_f(t[e]); }
                        *(u32x4*)(rowp + bj * HALF) = pack8(v[0], v[1]); } }
        }
    }
};
struct EpiGateMul {
    static constexpr bool PERM = true, AFTER_DRAIN = false;
    bf16_t* U; const bf16_t* G; int ldc;
    __device__ __forceinline__ void operator()(const f32x4 (&acc)[2][2][4][2], const Unit& u, int wr, int wc, int fr, int fq) const {
        const int row0 = u.pm * BM + wr * 64 + fr, col0 = u.pn * BM + wc * 32 + 8 * fq;
#pragma unroll
        for (int ai = 0; ai < 2; ++ai)
#pragma unroll
            for (int m = 0; m < 4; ++m) { const size_t off = (size_t)(row0 + ai * HALF + m * 16) * ldc + col0;
#pragma unroll
                for (int bj = 0; bj < 2; ++bj) { const u32x4 gw = *(const u32x4*)(G + off + bj * HALF);
                    f32x4 g0, g1;
                    g0[0] = __uint_as_float(gw.x << 16); g0[1] = __uint_as_float(gw.x & 0xffff0000u); g0[2] = __uint_as_float(gw.y << 16); g0[3] = __uint_as_float(gw.y & 0xffff0000u);
                    g1[0] = __uint_as_float(gw.z << 16); g1[1] = __uint_as_float(gw.z & 0xffff0000u); g1[2] = __uint_as_float(gw.w << 16); g1[3] = __uint_as_float(gw.w & 0xffff0000u);
                    *(u32x4*)(U + off + bj * HALF) = pack8(acc[ai][bj][m][0] * g0, acc[ai][bj][m][1] * g1); } }
    }
};

template <class Epi, class Sched, bool ALIGN_EPI = false, bool SP2 = false>
__device__ __forceinline__ void gemm_phase(PG8_LAS unsigned char* lds, const Gemm g, const Sched& S, const Epi& E) {
    const int tid = threadIdx.x, wid = __builtin_amdgcn_readfirstlane(tid >> 6), lane = tid & 63, wr = wid >> 2, wc = wid & 3, fr = lane & 15, fq = lane >> 4;
    const int K = g.K, nt = K / BK;
    unsigned voffA[2], voffB[2];
#pragma unroll
    for (int i = 0; i < 2; ++i) { int R, C; stage_rc(tid * 16 + i * 8192, R, C); const int Rb = Epi::PERM ? ((R & ~31) + perm32(R & 31)) : R;
        voffA[i] = (unsigned)(R * g.lda + C) * 2u; voffB[i] = (unsigned)(Rb * K + C) * 2u; }
    const size_t kstep = (size_t)(BK * 2);
    const size_t hstepA = (size_t)HALF * g.lda * 2, hstepB = (size_t)HALF * K * 2;
    const size_t tstepA = 2 * hstepA, tstepB = 2 * hstepB;
    const unsigned ldsw = (unsigned)wid * 1024u;
    const int aoff = lds_byte(wr * 64 + fr, fq * 8), boff = lds_byte(wc * 32 + fr, fq * 8);
#define PG8_SA(b, h) (((b) * 2 + (h)) * HTB)
#define PG8_SB(b, h) ((4 + (b) * 2 + (h)) * HTB)
#define PG8_STAGE(bufoff, gbase, voff) do { _Pragma("unroll") for (int _i = 0; _i < 2; ++_i) \
        __builtin_amdgcn_global_load_lds((const unsigned*)((const char*)(gbase) + (voff)[_i]), (PG8_LAS unsigned*)(lds + (bufoff) + ldsw + _i * 8192), 16, 0, 0); } while (0)
#define PG8_LDA(dst, b, h) do { _Pragma("unroll") for (int m = 0; m < 4; ++m) _Pragma("unroll") for (int k = 0; k < 2; ++k) dst[m][k] = *(const PG8_LAS bf16x8*)(lds + PG8_SA(b, h) + aoff + m * 2048 + k * 1024); } while (0)
#define PG8_LDB(dst, b, h) do { _Pragma("unroll") for (int n = 0; n < 2; ++n) _Pragma("unroll") for (int k = 0; k < 2; ++k) dst[n][k] = *(const PG8_LAS bf16x8*)(lds + PG8_SB(b, h) + boff + n * 2048 + k * 1024); } while (0)
#define PG8_MMA(ai, bj, At, Bt) do { __builtin_amdgcn_s_setprio(1); _Pragma("unroll") for (int m = 0; m < 4; ++m) _Pragma("unroll") for (int n = 0; n < 2; ++n) _Pragma("unroll") for (int k = 0; k < 2; ++k) \
        acc[ai][bj][m][n] = __builtin_amdgcn_mfma_f32_16x16x32_bf16(Bt[n][k], At[m][k], acc[ai][bj][m][n], 0, 0, 0); __builtin_amdgcn_s_setprio(0); } while (0)
#define PG8_WAIT_V(n) asm volatile("s_waitcnt vmcnt(" #n ")" ::: "memory")
#define PG8_WAIT_L(n) asm volatile("s_waitcnt lgkmcnt(" #n ")" ::: "memory")
#define PG8_BAR __builtin_amdgcn_s_barrier()
#define PG8_SCHED __builtin_amdgcn_sched_barrier(0)
    Unit cur, nxt; int ui = 0;
    if (!S.next(0, cur)) return;
    f32x4 acc[2][2][4][2];
#pragma unroll
    for (int a = 0; a < 2; ++a)
#pragma unroll
        for (int b = 0; b < 2; ++b)
#pragma unroll
            for (int m = 0; m < 4; ++m)
#pragma unroll
                for (int n = 0; n < 2; ++n) acc[a][b][m][n] = (f32x4){0.f, 0.f, 0.f, 0.f};
    bf16x8 At[4][2], B0[2][2], B1[2][2];
    const char* cA = (const char*)g.A + (size_t)cur.pm * tstepA + (size_t)((cur.pn / g.grp_tiles) * g.grp_cols) * 2; const char* cB = (const char*)g.Bt + (size_t)cur.pn * tstepB;
    S.a_ready(cur);
    if constexpr (SP2) {
        PG8_STAGE(PG8_SB(0, 0), cB, voffB); PG8_STAGE(PG8_SB(0, 1), cB + hstepB, voffB); PG8_STAGE(PG8_SA(0, 0), cA, voffA); PG8_STAGE(PG8_SA(0, 1), cA + hstepA, voffA);
        if (wr == 1) PG8_BAR;
        PG8_WAIT_V(2); PG8_BAR;
        PG8_STAGE(PG8_SB(1, 0), cB + kstep, voffB); PG8_STAGE(PG8_SA(1, 0), cA + kstep, voffA); PG8_STAGE(PG8_SB(1, 1), cB + hstepB + kstep, voffB);
        PG8_WAIT_V(6); PG8_BAR;
    } else {
        PG8_STAGE(PG8_SB(0, 0), cB, voffB); PG8_STAGE(PG8_SA(0, 0), cA, voffA); PG8_STAGE(PG8_SB(0, 1), cB + hstepB, voffB); PG8_STAGE(PG8_SA(0, 1), cA + hstepA, voffA);
        if (wr == 1) PG8_BAR;
        PG8_WAIT_V(4); PG8_BAR;
        PG8_STAGE(PG8_SB(1, 0), cB + kstep, voffB); PG8_STAGE(PG8_SA(1, 0), cA + kstep, voffA); PG8_STAGE(PG8_SB(1, 1), cB + hstepB + kstep, voffB);
        PG8_WAIT_V(6); PG8_BAR;
    }
    for (;;) {
        const bool has_next = S.next(ui + 1, nxt);
        const char* nA = has_next ? (const char*)g.A + (size_t)nxt.pm * tstepA + (size_t)((nxt.pn / g.grp_tiles) * g.grp_cols) * 2 : cA; const char* nB = has_next ? (const char*)g.Bt + (size_t)nxt.pn * tstepB : cB;
        for (int t = 0; t < nt; t += 2) {
            const bool last = (t == nt - 2);
            const char* a1 = cA + (size_t)(t + 1) * kstep;
            const char* a2 = last ? nA : cA + (size_t)(t + 2) * kstep; const char* b2 = last ? nB : cB + (size_t)(t + 2) * kstep;
            const char* a3 = a2 + kstep; const char* b3 = b2 + kstep;
            if (last && has_next) S.a_ready(nxt);
            if constexpr (SP2) {
            PG8_LDB(B0, 0, 0); PG8_LDB(B1, 0, 1); PG8_SCHED; PG8_LDA(At, 0, 0); PG8_STAGE(PG8_SA(1, 1), a1 + hstepA, voffA);
            PG8_WAIT_V(8); PG8_WAIT_L(0); PG8_BAR; PG8_MMA(0, 0, At, B0); PG8_MMA(0, 1, At, B1); PG8_BAR; PG8_SCHED;
            PG8_LDA(At, 0, 1); PG8_STAGE(PG8_SB(0, 0), b2, voffB); PG8_STAGE(PG8_SB(0, 1), b2 + hstepB, voffB); PG8_STAGE(PG8_SA(0, 0), a2, voffA);
            PG8_WAIT_V(8); PG8_WAIT_L(0); PG8_BAR; PG8_MMA(1, 0, At, B0); PG8_MMA(1, 1, At, B1); PG8_BAR; PG8_SCHED;
            PG8_LDB(B0, 1, 0); PG8_LDB(B1, 1, 1); PG8_SCHED; PG8_LDA(At, 1, 0); PG8_STAGE(PG8_SA(0, 1), a2 + hstepA, voffA);
            PG8_WAIT_V(8); PG8_WAIT_L(0); PG8_BAR; PG8_MMA(0, 0, At, B0); PG8_MMA(0, 1, At, B1); PG8_BAR; PG8_SCHED;
            PG8_LDA(At, 1, 1); PG8_STAGE(PG8_SB(1, 0), b3, voffB); PG8_STAGE(PG8_SB(1, 1), b3 + hstepB, voffB); PG8_STAGE(PG8_SA(1, 0), a3, voffA);
            PG8_WAIT_V(8); PG8_WAIT_L(0); PG8_BAR; PG8_MMA(1, 0, At, B0); PG8_MMA(1, 1, At, B1); PG8_BAR; PG8_SCHED;
            } else {
            PG8_LDB(B0, 0, 0); PG8_SCHED; PG8_LDA(At, 0, 0); PG8_STAGE(PG8_SA(1, 1), a1 + hstepA, voffA);
            PG8_WAIT_L(8); PG8_BAR; PG8_WAIT_L(0); PG8_MMA(0, 0, At, B0); PG8_BAR; PG8_SCHED;
            PG8_LDB(B1, 0, 1); PG8_STAGE(PG8_SB(0, 0), b2, voffB);
            PG8_BAR; PG8_WAIT_L(0); PG8_MMA(0, 1, At, B1); PG8_BAR;
            PG8_LDA(At, 0, 1); PG8_STAGE(PG8_SA(0, 0), a2, voffA);
            PG8_BAR; PG8_WAIT_L(0); PG8_MMA(1, 0, At, B0); PG8_BAR; PG8_SCHED;
            PG8_STAGE(PG8_SB(0, 1), b2 + hstepB, voffB);
            PG8_WAIT_V(6); PG8_BAR; PG8_MMA(1, 1, At, B1); PG8_BAR;
            PG8_LDB(B0, 1, 0); PG8_SCHED; PG8_LDA(At, 1, 0); PG8_STAGE(PG8_SA(0, 1), a2 + hstepA, voffA);
            PG8_WAIT_L(8); PG8_BAR; PG8_WAIT_L(0); PG8_MMA(0, 0, At, B0); PG8_BAR; PG8_SCHED;
            PG8_LDB(B1, 1, 1); PG8_STAGE(PG8_SB(1, 0), b3, voffB);
            PG8_BAR; PG8_WAIT_L(0); PG8_MMA(0, 1, At, B1); PG8_BAR;
            PG8_LDA(At, 1, 1); PG8_STAGE(PG8_SA(1, 0), a3, voffA);
            PG8_BAR; PG8_WAIT_L(0); PG8_MMA(1, 0, At, B0); PG8_BAR; PG8_SCHED;
            PG8_STAGE(PG8_SB(1, 1), b3 + hstepB, voffB);
            PG8_WAIT_V(6); PG8_BAR; PG8_MMA(1, 1, At, B1); PG8_BAR;
            }
        }
        if constexpr (ALIGN_EPI) { if (wr == 0) PG8_BAR; }
        if constexpr (!Epi::AFTER_DRAIN) { E(acc, cur, wr, wc, fr, fq); S.done(cur); }
        if (!has_next) break;
#pragma unroll
        for (int a = 0; a < 2; ++a)
#pragma unroll
            for (int b = 0; b < 2; ++b)
#pragma unroll
                for (int m = 0; m < 4; ++m)
#pragma unroll
                    for (int n = 0; n < 2; ++n) acc[a][b][m][n] = (f32x4){0.f, 0.f, 0.f, 0.f};
        cur = nxt; cA = nA; cB = nB; ++ui;
        if constexpr (ALIGN_EPI) { if (wr == 1) PG8_BAR; }
    }
    PG8_WAIT_V(0);
    if constexpr (!ALIGN_EPI) { if (wr == 0) PG8_BAR; }
    PG8_BAR;
    if constexpr (Epi::AFTER_DRAIN) { E.fused(acc, cur, wr, wc, fr, fq, lds, wid, lane); S.done(cur); }
#undef PG8_SA
#undef PG8_SB
#undef PG8_STAGE
#undef PG8_LDA
#undef PG8_LDB
#undef PG8_MMA
#undef PG8_WAIT_V
#undef PG8_WAIT_L
#undef PG8_BAR
#undef PG8_SCHED
}
}
namespace att {
#define ALAS __attribute__((address_space(3)))
typedef unsigned short bf16_t;
typedef short bf16x8 __attribute__((ext_vector_type(8)));
typedef short s16x4 __attribute__((ext_vector_type(4)));
typedef float f32x16 __attribute__((ext_vector_type(16)));
typedef float f32x4 __attribute__((ext_vector_type(4)));
typedef unsigned u32x4 __attribute__((ext_vector_type(4)));
typedef unsigned u32x2 __attribute__((ext_vector_type(2)));
constexpr int SEQ = 2048, QP = 3072, YP = 1024;
constexpr int KBUF = 0, VBUF = 16384, LFC_OFF = 32768, RED_OFF = 40960, ATT_LDS = 41216;
typedef float f32x2_t __attribute__((ext_vector_type(2))); typedef __bf16 bf16x2_t __attribute__((ext_vector_type(2)));
__device__ __forceinline__ unsigned cvtpk(float lo, float hi) { f32x2_t v = {lo, hi}; bf16x2_t b = __builtin_convertvector(v, bf16x2_t); return __builtin_bit_cast(unsigned, b); }
__device__ __forceinline__ s16x4 vtr(const ALAS unsigned char* p) { return __builtin_bit_cast(s16x4, __builtin_amdgcn_ds_read_tr16_b64_v4i16((ALAS s16x4*)p)); }
__device__ __forceinline__ float halfswap_max(float v) { auto rr = __builtin_amdgcn_permlane32_swap(__float_as_uint(v), __float_as_uint(v), false, false); return fmaxf(__uint_as_float(rr[0]), __uint_as_float(rr[1])); }
__device__ __forceinline__ float halfswap_sum(float v) { auto rr = __builtin_amdgcn_permlane32_swap(__float_as_uint(v), __float_as_uint(v), false, false); return __uint_as_float(rr[0]) + __uint_as_float(rr[1]); }

template <int MODE>
__device__ __forceinline__ void attn_unit(int b, int h, int qb, const bf16_t* __restrict__ QKV, bf16_t* __restrict__ Y, ALAS unsigned char* lds) {
    const int tid = threadIdx.x, lane = tid & 63, r32 = lane & 31, hi = lane >> 5, wid = __builtin_amdgcn_readfirstlane(tid >> 6);
    const int q0 = qb * 256, qw = q0 + 32 * wid, q = qw + r32;
    const size_t rowbase = (size_t)b * SEQ;
    const int colq = (MODE ? 1536 : 0) + h * 64, colk = colq + 512, colv = colq + 1024;
    bf16x8 qr[4];
    { const bf16_t* Qp = QKV + (rowbase + q) * QP + colq + hi * 8;
#pragma unroll
      for (int d0 = 0; d0 < 4; ++d0) qr[d0] = *(const bf16x8*)(Qp + d0 * 16); }
    const bf16_t* ksrc = QKV + (rowbase + lane) * QP + colk + wid * 8;
    const bf16_t* vsrc = QKV + (rowbase + 16 * (wid & 3) + (lane >> 2)) * QP + colv + (wid >> 2) * 32 + (lane & 3) * 8;
    const int sto = wid * 1024 + lane * 16;
    const int NT = (q0 + 256) / 64;
    const int koff = hi * 1024 + r32 * 16;
    const int voff = ((lane >> 4) & 1) * 32 + (lane & 3) * 8 + (4 * hi + ((lane & 15) >> 2)) * 64;
    f32x16 o0, o1;
#pragma unroll
    for (int r = 0; r < 16; ++r) { o0[r] = 0.f; o1[r] = 0.f; }
    float m_run = -1e30f, l_run = 0.f, carry = 0.f;
    { const int t0 = MODE ? 0 : NT - 1;
      const u32x4 kr = *(const u32x4*)(ksrc + (size_t)t0 * 64 * QP), vr = *(const u32x4*)(vsrc + (size_t)t0 * 64 * QP);
      *(ALAS u32x4*)(lds + KBUF + sto) = kr; *(ALAS u32x4*)(lds + VBUF + sto) = vr; }
    __syncthreads();
    for (int i = 0; i < NT; ++i) {
        const int t = MODE ? i : NT - 1 - i, tn = MODE ? t + 1 : t - 1;
        const bool more = (i + 1 < NT);
        u32x4 kr = {0u, 0u, 0u, 0u}, vr = {0u, 0u, 0u, 0u};
        if (more) { kr = *(const u32x4*)(ksrc + (size_t)tn * 64 * QP); vr = *(const u32x4*)(vsrc + (size_t)tn * 64 * QP); }
        const int bo = (i & 1) * 8192;
        if (64 * t <= qw + 31) {
            f32x16 p0, p1;
#pragma unroll
            for (int r = 0; r < 16; ++r) { p0[r] = 0.f; p1[r] = 0.f; }
#pragma unroll
            for (int d0 = 0; d0 < 4; ++d0) {
                const bf16x8 k0 = *(const ALAS bf16x8*)(lds + KBUF + bo + koff + d0 * 2048);
                const bf16x8 k1 = *(const ALAS bf16x8*)(lds + KBUF + bo + koff + d0 * 2048 + 512);
                p0 = __builtin_amdgcn_mfma_f32_32x32x16_bf16(k0, qr[d0], p0, 0, 0, 0);
                p1 = __builtin_amdgcn_mfma_f32_32x32x16_bf16(k1, qr[d0], p1, 0, 0, 0);
            }
            const int kv0 = 64 * t + 4 * hi;
            const bool diag = (64 * t + 63 >= qw);
            if (MODE == 1) {
#pragma unroll
                for (int g4 = 0; g4 < 4; ++g4) {
                    const f32x4 b0 = *(const ALAS f32x4*)(lds + LFC_OFF + (kv0 + 8 * g4) * 4), b1 = *(const ALAS f32x4*)(lds + LFC_OFF + (kv0 + 32 + 8 * g4) * 4);
#pragma unroll
                    for (int e = 0; e < 4; ++e) { p0[4 * g4 + e] += b0[e]; p1[4 * g4 + e] += b1[e]; }
                }
                if (diag) {
#pragma unroll
                    for (int r = 0; r < 16; ++r) { const int kv = kv0 + (r & 3) + 8 * (r >> 2); if (kv > q) p0[r] = -INFINITY; if (kv + 32 > q) p1[r] = -INFINITY; }
                }
                float mx = fmaxf(p0[0], p1[0]);
#pragma unroll
                for (int r = 1; r < 16; ++r) mx = fmaxf(mx, fmaxf(p0[r], p1[r]));
                mx = halfswap_max(mx);
                const float m_new = fmaxf(m_run, mx), f = __builtin_amdgcn_exp2f(m_run - m_new);
                m_run = m_new;
                float rs = 0.f;
#pragma unroll
                for (int r = 0; r < 16; ++r) { p0[r] = __builtin_amdgcn_exp2f(p0[r] - m_new); p1[r] = __builtin_amdgcn_exp2f(p1[r] - m_new); rs += p0[r] + p1[r]; }
                l_run = l_run * f + rs;
#pragma unroll
                for (int r = 0; r < 16; ++r) { o0[r] *= f; o1[r] *= f; }
            } else {
                f32x16 n0, n1;
#pragma unroll
                for (int r = 0; r < 16; ++r) {
                    { const float z = p0[r], lab = __builtin_amdgcn_logf(1.0f + __builtin_amdgcn_exp2f(-fabsf(z))), L = fminf(z, 0.f) - lab; p0[r] = L; n0[r] = L - z; }
                    { const float z = p1[r], lab = __builtin_amdgcn_logf(1.0f + __builtin_amdgcn_exp2f(-fabsf(z))), L = fminf(z, 0.f) - lab; p1[r] = L; n1[r] = L - z; }
                }
                if (diag) {
#pragma unroll
                    for (int r = 0; r < 16; ++r) { const int kv = kv0 + (r & 3) + 8 * (r >> 2);
                        if (kv >= q) { p0[r] = -INFINITY; n0[r] = 0.f; } if (kv + 32 >= q) { p1[r] = -INFINITY; n1[r] = 0.f; } }
                }
                float T[8], X[8];
#pragma unroll
                for (int k = 0; k < 8; ++k) {
                    const float gsum = (k < 4) ? ((n0[4 * k] + n0[4 * k + 1]) + (n0[4 * k + 2] + n0[4 * k + 3])) : ((n1[4 * (k - 4)] + n1[4 * (k - 4) + 1]) + (n1[4 * (k - 4) + 2] + n1[4 * (k - 4) + 3]));
                    auto rr = __builtin_amdgcn_permlane32_swap(__float_as_uint(gsum), __float_as_uint(gsum), false, false);
                    const float vlo = __uint_as_float(rr[0]), vhi = __uint_as_float(rr[1]);
                    T[k] = vlo + vhi; X[k] = hi ? 0.f : vhi;
                }
                float suf = carry;
#pragma unroll
                for (int k = 7; k >= 0; --k) {
                    const float base = suf + X[k];
                    if (k < 4) { const int r = 4 * k; const float b3 = base, b2 = b3 + n0[r + 3], b1 = b2 + n0[r + 2], b0 = b1 + n0[r + 1];
                        p0[r] = __builtin_amdgcn_exp2f(p0[r] + b0); p0[r + 1] = __builtin_amdgcn_exp2f(p0[r + 1] + b1); p0[r + 2] = __builtin_amdgcn_exp2f(p0[r + 2] + b2); p0[r + 3] = __builtin_amdgcn_exp2f(p0[r + 3] + b3); }
                    else { const int r = 4 * (k - 4); const float b3 = base, b2 = b3 + n1[r + 3], b1 = b2 + n1[r + 2], b0 = b1 + n1[r + 1];
                        p1[r] = __builtin_amdgcn_exp2f(p1[r] + b0); p1[r + 1] = __builtin_amdgcn_exp2f(p1[r + 1] + b1); p1[r + 2] = __builtin_amdgcn_exp2f(p1[r + 2] + b2); p1[r + 3] = __builtin_amdgcn_exp2f(p1[r + 3] + b3); }
                    suf += T[k];
                }
                carry = suf;
            }
            bf16x8 pw[4];
#pragma unroll
            for (int ks = 0; ks < 4; ++ks) { const int r = 8 * (ks & 1); u32x4 w;
                if (ks < 2) { w.x = cvtpk(p0[r], p0[r + 1]); w.y = cvtpk(p0[r + 2], p0[r + 3]); w.z = cvtpk(p0[r + 4], p0[r + 5]); w.w = cvtpk(p0[r + 6], p0[r + 7]); }
                else        { w.x = cvtpk(p1[r], p1[r + 1]); w.y = cvtpk(p1[r + 2], p1[r + 3]); w.z = cvtpk(p1[r + 4], p1[r + 5]); w.w = cvtpk(p1[r + 6], p1[r + 7]); }
                pw[ks] = __builtin_bit_cast(bf16x8, w); }
#pragma unroll
            for (int ks = 0; ks < 4; ++ks) {
                const ALAS unsigned char* vp = lds + VBUF + bo + voff + ks * 1024;
                const s16x4 a0 = vtr(vp), a1 = vtr(vp + 512), c0 = vtr(vp + 4096), c1 = vtr(vp + 4096 + 512);
                const bf16x8 vf0 = {a0[0], a0[1], a0[2], a0[3], a1[0], a1[1], a1[2], a1[3]}, vf1 = {c0[0], c0[1], c0[2], c0[3], c1[0], c1[1], c1[2], c1[3]};
                o0 = __builtin_amdgcn_mfma_f32_32x32x16_bf16(vf0, pw[ks], o0, 0, 0, 0);
                o1 = __builtin_amdgcn_mfma_f32_32x32x16_bf16(vf1, pw[ks], o1, 0, 0, 0);
            }
        }
        if (more) { const int bn = ((i + 1) & 1) * 8192; *(ALAS u32x4*)(lds + KBUF + bn + sto) = kr; *(ALAS u32x4*)(lds + VBUF + bn + sto) = vr; }
        __syncthreads();
    }
    float inv = 1.0f;
    if (MODE == 1) { const float lt = halfswap_sum(l_run); inv = 1.0f / lt; }
    bf16_t* Yp = Y + (rowbase + q) * YP + (MODE ? 512 : 0) + h * 64 + 4 * hi;
#pragma unroll
    for (int g4 = 0; g4 < 4; ++g4) {
        u32x2 w0, w1;
        w0.x = cvtpk(o0[4 * g4] * inv, o0[4 * g4 + 1] * inv); w0.y = cvtpk(o0[4 * g4 + 2] * inv, o0[4 * g4 + 3] * inv);
        w1.x = cvtpk(o1[4 * g4] * inv, o1[4 * g4 + 1] * inv); w1.y = cvtpk(o1[4 * g4 + 2] * inv, o1[4 * g4 + 3] * inv);
        *(u32x2*)(Yp + 8 * g4) = w0; *(u32x2*)(Yp + 32 + 8 * g4) = w1;
    }
}
__device__ __forceinline__ void fox_bias_scan(const float* __restrict__ LF, int bh, ALAS unsigned char* lds) {
    const int tid = threadIdx.x, lane = tid & 63, wid = tid >> 6;
    const f32x4 v = *(const f32x4*)(LF + (size_t)bh * SEQ + 4 * tid);
    const float s1 = v[0], s2 = s1 + v[1], s3 = s2 + v[2], s4 = s3 + v[3];
    float inc = s4;
#pragma unroll
    for (int o = 1; o < 64; o <<= 1) { const float up = __shfl_up(inc, o); if (lane >= o) inc += up; }
    ALAS float* red = (ALAS float*)(lds + RED_OFF);
    if (lane == 63) red[wid] = inc;
    __syncthreads();
    float woff = 0.f;
    for (int w = 0; w < wid; ++w) woff += red[w];
    const float ex = woff + inc - s4;
    const float c = -1.4426950408889634f;
    f32x4 o; o[0] = c * (ex + s1); o[1] = c * (ex + s2); o[2] = c * (ex + s3); o[3] = c * (ex + s4);
    *(ALAS f32x4*)(lds + LFC_OFF + 16 * tid) = o;
    __syncthreads();
}
}
namespace cg = cooperative_groups;
constexpr int NWAVES = 8;
constexpr int BATCH = 8, SEQ = 2048, D = 1024, FF = 2816, M = BATCH * SEQ, INC = 3080;
constexpr float RMS_EPS = 1e-6f;
constexpr float C2 = 0.125f * 1.4426950408889634f;
constexpr size_t MiB = 1u << 20;
constexpr size_t WS_LF = 1 * MiB;
constexpr size_t WS_W1GU = 2 * MiB, WS_W1D = 13 * MiB, WS_W2GU = 19 * MiB, WS_W2D = 30 * MiB, WS_WQKVG = 36 * MiB, WS_WUP = 46 * MiB, WS_WOUT = 48 * MiB;
constexpr size_t WS_XN = 52 * MiB;
constexpr size_t WS_BIG = 84 * MiB;
constexpr size_t WS_GATES = 180 * MiB;
constexpr size_t WS_END = 244 * MiB;
constexpr int LDS_BYTES = 147456;

typedef unsigned short bf16;
typedef unsigned v4u __attribute__((ext_vector_type(4)));
typedef float f32x4 __attribute__((ext_vector_type(4)));
#define LAS __attribute__((address_space(3)))
#define LDS_WAIT() asm volatile("s_waitcnt lgkmcnt(0)" ::: "memory")
__device__ __forceinline__ unsigned pk2(float lo, float hi) { return pg8::cvt_pk_bf16(lo, hi); }
__device__ __forceinline__ float wave_sum(float v) {
#pragma unroll
    for (int o = 1; o < 64; o <<= 1) v += __shfl_xor(v, o);
    return v;
}
__device__ __forceinline__ void transpose_item(const float* __restrict__ W, int ldw, int k0, int n0, bf16* __restrict__ WT, int ldt, int drow0, int dk0, LAS float* scr, int lane) {
#pragma unroll 8
    for (int i = 0; i < 32; ++i) { const int kk = 2 * i + (lane >> 5); scr[kk * 33 + (lane & 31)] = W[(size_t)(k0 + kk) * ldw + n0 + (lane & 31)]; }
    LDS_WAIT(); asm volatile("" ::: "memory");
    const int c = lane & 7;
#pragma unroll
    for (int j = 0; j < 4; ++j) { const int n = (lane >> 3) + 8 * j; const LAS float* s = scr + (8 * c) * 33 + n;
        v4u o; o.x = pk2(s[0 * 33], s[1 * 33]); o.y = pk2(s[2 * 33], s[3 * 33]); o.z = pk2(s[4 * 33], s[5 * 33]); o.w = pk2(s[6 * 33], s[7 * 33]);
        *(v4u*)(WT + (size_t)(drow0 + n) * ldt + dk0 + k0 + 8 * c) = o; }
    LDS_WAIT(); asm volatile("" ::: "memory");
}
#define XB_TMO      128
#define XB_XCNT(j)  (256  + 64 * (j))
#define XB_XSUB(j)  (1280 + 64 * (j))
#define XB_XGEN(j)  (2304 + 64 * (j))
#define XB_TOP      3328
#define XB_TOPGEN   3392
#define XCD_BAR_WORDS 3456
#define XB_SPIN_CAP (1u << 18)

__device__ __forceinline__ unsigned xb_ld(unsigned* p)              { return __hip_atomic_load(p, __ATOMIC_RELAXED, __HIP_MEMORY_SCOPE_AGENT); }
__device__ __forceinline__ unsigned xb_add(unsigned* p, unsigned v) { return __hip_atomic_fetch_add(p, v, __ATOMIC_RELAXED, __HIP_MEMORY_SCOPE_AGENT); }
__device__ __forceinline__ unsigned xb_xcc_id() { return (unsigned)__builtin_amdgcn_s_getreg((3 << 11) | 20) & 0xFu; }
#define XB_SPIN(cond, bar) do { unsigned _sp = 0; while (cond) { __builtin_amdgcn_s_sleep(1); \
    if ((++_sp & 255u) == 0u) { if (xb_ld(&(bar)[XB_TMO])) break; if (_sp > XB_SPIN_CAP) { atomicAdd(&(bar)[XB_TMO], 1u); break; } } } } while (0)

struct XcdBarrier {
    unsigned* bar; unsigned x;
    volatile LAS unsigned* st;
};

__device__ __forceinline__ XcdBarrier xcd_barrier_post(unsigned* bar, volatile LAS unsigned* st) {
    XcdBarrier b; b.bar = bar; b.x = xb_xcc_id(); b.st = st;
    if (threadIdx.x == 0) (void)xb_add(&bar[XB_XCNT(b.x)], 1u);
    return b;
}
__device__ __forceinline__ void xcd_barrier_complete(unsigned* bar, unsigned x, unsigned& nloc, unsigned& nx) {
    const unsigned G = gridDim.x * gridDim.y * gridDim.z;
    unsigned sum, cnt, mine, sp = 0u;
    for (;;) {
        sum = 0u; cnt = 0u; mine = 0u;
#pragma unroll
        for (unsigned j = 0; j < 16; ++j) { const unsigned c = xb_ld(&bar[XB_XCNT(j)]); sum += c; cnt += (c > 0u) ? 1u : 0u; mine = (j == x) ? c : mine; }
        if (sum == G) break;
        __builtin_amdgcn_s_sleep(1);
        if ((++sp & 255u) == 0u) { if (xb_ld(&bar[XB_TMO])) break; if (sp > XB_SPIN_CAP) { atomicAdd(&bar[XB_TMO], 1u); break; } }
    }
    nloc = mine > 0u ? mine : 1u; nx = cnt > 0u ? cnt : 1u;
}

__device__ __forceinline__ void xcd_barrier(const XcdBarrier& b) {
    asm volatile("s_waitcnt vmcnt(0)" ::: "memory");
    __syncthreads();
    if (threadIdx.x == 0) {
        unsigned* bar = b.bar;
        __builtin_amdgcn_s_waitcnt(0);
        unsigned nloc = b.st[0], nx = b.st[1];
        if (nloc == 0u) { xcd_barrier_complete(bar, b.x, nloc, nx); b.st[0] = nloc; b.st[1] = nx; }
        const unsigned old = xb_add(&bar[XB_XSUB(b.x)], 1u);
        const unsigned gen = old / nloc;
        if (old + 1u == (gen + 1u) * nloc) {
            __builtin_amdgcn_fence(__ATOMIC_RELEASE, "agent");
            asm volatile("s_waitcnt vmcnt(0)" ::: "memory");
            const unsigned og = xb_add(&bar[XB_TOP], 1u);
            const unsigned tg = og / nx;
            if (og + 1u == (tg + 1u) * nx) xb_add(&bar[XB_TOPGEN], 1u);
            else XB_SPIN(xb_ld(&bar[XB_TOPGEN]) == tg, bar);
            __builtin_amdgcn_fence(__ATOMIC_ACQUIRE, "agent");
            xb_add(&bar[XB_XGEN(b.x)], 1u);
            asm volatile("s_waitcnt vmcnt(0)" ::: "memory");
        } else {
            XB_SPIN(xb_ld(&bar[XB_XGEN(b.x)]) == gen, bar);
            __builtin_amdgcn_fence(__ATOMIC_ACQUIRE, "agent");
            asm volatile("s_waitcnt vmcnt(0)" ::: "memory");
        }
    }
    __syncthreads();
}

struct Args { const float* in[18]; float* out; unsigned char* ws; };
struct WItem { const float* W; int ldw, ncols32, K; bf16* WT; int ldt, mode, dk0; };
__device__ __forceinline__ void conv_matrix(const float* W, int ldw, int ncols, int K, bf16* WT, int ldt, int mode, int rowadd, int dk0, int& it, int gw, int NGW, LAS float* scr, int lane) {
    const int nb32 = ncols / 32, nitems = (K / 64) * nb32;
    int first = it + ((gw - it) % NGW + NGW) % NGW;
    for (int g = first; g < it + nitems; g += NGW) {
        const int r = g - it, kb = r / nb32, nb = r % nb32, k0 = 64 * kb, n0 = 32 * nb;
        int drow0 = n0 + rowadd;
        if (mode == 1) drow0 = 256 * (n0 / 128) + (n0 % 128);
        else if (mode == 2) drow0 = 256 * (n0 / 128) + 128 + (n0 % 128);
        transpose_item(W, ldw, k0, n0, WT, ldt, drow0, dk0, scr, lane);
    }
    it += nitems;
}
__device__ __forceinline__ void rms_row(const float* xrow, const f32x4 (&g)[4], f32x4 (&v)[4], int lane) {
    const f32x4* xr = (const f32x4*)xrow + lane; float s2 = 0.f;
#pragma unroll
    for (int j = 0; j < 4; ++j) { v[j] = xr[64 * j]; s2 += (v[j].x * v[j].x + v[j].y * v[j].y) + (v[j].z * v[j].z + v[j].w * v[j].w); }
    const float rstd = 1.0f / sqrtf(wave_sum(s2) * (1.0f / D) + RMS_EPS);
#pragma unroll
    for (int j = 0; j < 4; ++j) v[j] = v[j] * rstd * g[j];
}
__device__ __forceinline__ void store_row_bf16(bf16* orow, const f32x4 (&v)[4], int lane) {
    unsigned long long* o8 = (unsigned long long*)orow + lane;
#pragma unroll
    for (int j = 0; j < 4; ++j) o8[64 * j] = (unsigned long long)pk2(v[j].x, v[j].y) | ((unsigned long long)pk2(v[j].z, v[j].w) << 32);
}
__device__ __forceinline__ void norm_phase_bf16(const float* X, const float* gain, bf16* XN, int gw, int NGW, int lane) {
    f32x4 g[4];
#pragma unroll
    for (int j = 0; j < 4; ++j) g[j] = ((const f32x4*)gain)[lane + 64 * j];
    for (int m = gw; m < M; m += NGW) { f32x4 v[4]; rms_row(X + (size_t)m * D, g, v, lane); store_row_bf16(XN + (size_t)m * D, v, lane); }
}

#ifndef USE_CG_SYNC
#define USE_CG_SYNC 1
#endif
#if USE_CG_SYNC
#define GRID_SYNC() do { asm volatile("s_waitcnt vmcnt(0) lgkmcnt(0)" ::: "memory"); grid.sync(); __builtin_amdgcn_fence(__ATOMIC_ACQUIRE, "agent"); asm volatile("s_waitcnt vmcnt(0)" ::: "memory"); } while (0)
#else
#define GRID_SYNC() xcd_barrier(bar)
#endif
__global__ void __launch_bounds__(NWAVES * 64, 2) mk_fwd(Args args) {
    extern __shared__ __attribute__((aligned(16))) unsigned char lds_raw[];
    LAS unsigned char* lds = (LAS unsigned char*)lds_raw;
    cg::grid_group grid = cg::this_grid(); (void)grid;
    const int tid = threadIdx.x, lane = tid & 63, wave = __builtin_amdgcn_readfirstlane(tid >> 6);
    const int G = gridDim.x, bx = blockIdx.x;
    const int vcu = (G % 8 == 0) ? (bx % 8) * (G / 8) + bx / 8 : bx;
    const int gw = vcu * NWAVES + wave, NGW = G * NWAVES;
    unsigned char* ws = args.ws;
    const float* x = args.in[0];
    float* X = args.out;
    bf16* W1GU = (bf16*)(ws + WS_W1GU); bf16* W1D = (bf16*)(ws + WS_W1D); bf16* W2GU = (bf16*)(ws + WS_W2GU); bf16* W2D = (bf16*)(ws + WS_W2D);
    bf16* WQKVG = (bf16*)(ws + WS_WQKVG); bf16* WUP = (bf16*)(ws + WS_WUP); bf16* WOUT = (bf16*)(ws + WS_WOUT);
    bf16* XN = (bf16*)(ws + WS_XN); bf16* BIG = (bf16*)(ws + WS_BIG); bf16* GATES = (bf16*)(ws + WS_GATES);
    float* LF = (float*)(ws + WS_LF);
    volatile LAS unsigned* misc = (volatile LAS unsigned*)(lds + 131072 + 1024);
    if (tid < 2) misc[tid] = 0u;
    __syncthreads();
    XcdBarrier bar = xcd_barrier_post((unsigned*)ws, misc);

    {
        LAS float* scr = (LAS float*)(lds + wave * 16384);
        int it = 0;
        conv_matrix(args.in[2], FF, FF, D, W1GU, D, 1, 0, 0, it, gw, NGW, scr, lane);
        conv_matrix(args.in[3], FF, FF, D, W1GU, D, 2, 0, 0, it, gw, NGW, scr, lane);
        conv_matrix(args.in[4], D, D, FF, W1D, FF, 0, 0, 0, it, gw, NGW, scr, lane);
        conv_matrix(args.in[14], FF, FF, D, W2GU, D, 1, 0, 0, it, gw, NGW, scr, lane);
        conv_matrix(args.in[15], FF, FF, D, W2GU, D, 2, 0, 0, it, gw, NGW, scr, lane);
        conv_matrix(args.in[16], D, D, FF, W2D, FF, 0, 0, 0, it, gw, NGW, scr, lane);
        conv_matrix(args.in[6], INC, 3072, D, WQKVG, D, 0, 0, 0, it, gw, NGW, scr, lane);
        conv_matrix(args.in[8], 2048, 2048, D, WQKVG, D, 0, 3072, 0, it, gw, NGW, scr, lane);
        conv_matrix(args.in[10], D, D, 512, WUP, 512, 0, 0, 0, it, gw, NGW, scr, lane);
        conv_matrix(args.in[11], D, D, 512, WUP, 512, 0, 1024, 0, it, gw, NGW, scr, lane);
        conv_matrix(args.in[12], D, D, D, WOUT, 2048, 0, 0, 0, it, gw, NGW, scr, lane);
        conv_matrix(args.in[12], D, D, D, WOUT, 2048, 0, 0, 1024, it, gw, NGW, scr, lane);
        f32x4 g[4];
#pragma unroll
        for (int j = 0; j < 4; ++j) g[j] = ((const f32x4*)args.in[1])[lane + 64 * j];
        for (int m = gw; m < M; m += NGW) {
            const f32x4* xr = (const f32x4*)(x + (size_t)m * D) + lane; f32x4* xo = (f32x4*)(X + (size_t)m * D) + lane;
#pragma unroll
            for (int j = 0; j < 4; ++j) xo[64 * j] = xr[64 * j];
            f32x4 v[4]; rms_row(x + (size_t)m * D, g, v, lane); store_row_bf16(XN + (size_t)m * D, v, lane);
        }
    }
    GRID_SYNC();
    { pg8::Gemm g{XN, W1GU, M, 2 * FF, D, D, 1 << 20, 0}; pg8::StaticOrder S; S.init(M, 2 * FF, G, bx);
      pg8::EpiSwiGLU E{BIG, FF};
      pg8::gemm_phase<pg8::EpiSwiGLU, pg8::StaticOrder, true, true>(lds, g, S, E); }
    GRID_SYNC();
    { pg8::Gemm g{BIG, W1D, M, D, FF, FF, 1 << 20, 0}; pg8::StaticOrder S; S.init(M, D, G, bx);
      pg8::EpiResF32 E{X, D, 0.5f};
      pg8::gemm_phase<pg8::EpiResF32, pg8::StaticOrder, true, true>(lds, g, S, E); }
    GRID_SYNC();
    {
        f32x4 g[4];
#pragma unroll
        for (int j = 0; j < 4; ++j) g[j] = ((const f32x4*)args.in[5])[lane + 64 * j];
        const float* w_in = args.in[6];
        f32x4 wf[4][4][2];
#pragma unroll
        for (int j = 0; j < 4; ++j)
#pragma unroll
            for (int e = 0; e < 4; ++e) { const float* p = w_in + (size_t)(256 * j + 4 * lane + e) * INC + 3072; wf[j][e][0] = *(const f32x4*)p; wf[j][e][1] = *(const f32x4*)(p + 4); }
        const float bfg = args.in[7][lane & 7];
        for (int m = gw; m < M; m += NGW) {
            f32x4 v[4]; rms_row(X + (size_t)m * D, g, v, lane); store_row_bf16(XN + (size_t)m * D, v, lane);
            f32x4 a0 = {0.f, 0.f, 0.f, 0.f}, a1 = {0.f, 0.f, 0.f, 0.f};
#pragma unroll
            for (int j = 0; j < 4; ++j)
#pragma unroll
                for (int e = 0; e < 4; ++e) { a0 += wf[j][e][0] * v[j][e]; a1 += wf[j][e][1] * v[j][e]; }
            float fl[8] = {a0[0], a0[1], a0[2], a0[3], a1[0], a1[1], a1[2], a1[3]};
#pragma unroll
            for (int c = 0; c < 8; ++c) fl[c] = wave_sum(fl[c]);
            float mine = fl[0];
#pragma unroll
            for (int c = 1; c < 8; ++c) mine = ((lane & 7) == c) ? fl[c] : mine;
            if (lane < 8) { const float t = mine + bfg; const float ls = fminf(t, 0.f) - log1pf(expf(-fabsf(t)));
                LF[(size_t)((m / SEQ) * 8 + lane) * SEQ + (m % SEQ)] = ls; }
        }
    }
    GRID_SYNC();
    { pg8::Gemm g{XN, WQKVG, M, 5120, D, D, 1 << 20, 0}; pg8::StaticOrder S; S.init(M, 5120, G, bx);
      pg8::EpiQKVG E{BIG, GATES, args.in[9], C2};
      pg8::gemm_phase<pg8::EpiQKVG, pg8::StaticOrder, true, true>(lds, g, S, E); }
    GRID_SYNC();
    for (int pi = vcu; pi < 256; pi += G) {
        const int bh = pi >> 2, s = pi & 3, b = bh >> 3, h = bh & 7;
        att::attn_unit<0>(b, h, 7 - s, BIG, XN, lds);
        att::attn_unit<0>(b, h, s, BIG, XN, lds);
        att::fox_bias_scan(LF, bh, lds);
        att::attn_unit<1>(b, h, 7 - s, BIG, XN, lds);
        att::attn_unit<1>(b, h, s, BIG, XN, lds);
    }
    GRID_SYNC();
    { pg8::Gemm g{XN, WUP, M, 2048, 512, 1024, 4, 512}; pg8::StaticOrder S; S.init(M, 2048, G, bx);
      pg8::EpiGateMul E{BIG, GATES, 2048};
      pg8::gemm_phase<pg8::EpiGateMul, pg8::StaticOrder, true, true>(lds, g, S, E); }
    GRID_SYNC();
    { pg8::Gemm g{BIG, WOUT, M, D, 2048, 2048, 1 << 20, 0}; pg8::StaticOrder S; S.init(M, D, G, bx);
      pg8::EpiResF32 E{X, D, 1.0f};
      pg8::gemm_phase<pg8::EpiResF32, pg8::StaticOrder, true, true>(lds, g, S, E); }
    GRID_SYNC();
    norm_phase_bf16(X, args.in[13], XN, gw, NGW, lane);
    GRID_SYNC();
    { pg8::Gemm g{XN, W2GU, M, 2 * FF, D, D, 1 << 20, 0}; pg8::StaticOrder S; S.init(M, 2 * FF, G, bx);
      pg8::EpiSwiGLU E{BIG, FF};
      pg8::gemm_phase<pg8::EpiSwiGLU, pg8::StaticOrder, true, true>(lds, g, S, E); }
    GRID_SYNC();
    { pg8::Gemm g{BIG, W2D, M, D, FF, FF, 1 << 20, 0}; pg8::StaticOrder S; S.init(M, D, G, bx);
      pg8::EpiResF32 E{X, D, 0.5f};
      pg8::gemm_phase<pg8::EpiResF32, pg8::StaticOrder, true, true>(lds, g, S, E); }
    GRID_SYNC();
    {
        f32x4 g[4];
#pragma unroll
        for (int j = 0; j < 4; ++j) g[j] = ((const f32x4*)args.in[17])[lane + 64 * j];
        for (int m = gw; m < M; m += NGW) { f32x4 v[4]; rms_row(X + (size_t)m * D, g, v, lane); f32x4* xo = (f32x4*)(X + (size_t)m * D) + lane;
#pragma unroll
            for (int j = 0; j < 4; ++j) xo[64 * j] = v[j]; }
    }
}

extern "C" void kernel_launch(void* const* d_in, const int* in_sizes, int n_in, void* d_out, int out_size, void* d_ws, size_t ws_size, hipStream_t stream) {
    static int grid = 0;
    if (grid == 0) {
        if (n_in != 18 || in_sizes[0] != M * D || out_size != M * D || ws_size < WS_END) { fprintf(stderr, "kernel_launch: unexpected problem (n_in %d, in0 %d, out %d, ws %zu)\n", n_in, n_in > 0 ? in_sizes[0] : -1, out_size, ws_size); grid = -1; return; }
        int dev = 0, cus = 0, per_cu = 0;
        (void)hipGetDevice(&dev); (void)hipDeviceGetAttribute(&cus, hipDeviceAttributeMultiprocessorCount, dev);
        if (hipFuncSetAttribute((const void*)mk_fwd, hipFuncAttributeMaxDynamicSharedMemorySize, LDS_BYTES) != hipSuccess) { fprintf(stderr, "kernel_launch: hipFuncSetAttribute failed\n"); grid = -1; return; }
        if (hipOccupancyMaxActiveBlocksPerMultiprocessor(&per_cu, (const void*)mk_fwd, NWAVES * 64, LDS_BYTES) != hipSuccess || per_cu < 1) { fprintf(stderr, "kernel_launch: occupancy query gave %d\n", per_cu); per_cu = 1; (void)hipGetLastError(); }
        grid = cus * per_cu;
    }
    if (grid < 0) return;
    if (hipMemsetAsync(d_ws, 0, 16384, stream) != hipSuccess) { fprintf(stderr, "kernel_launch: memset failed\n"); return; }
    Args a{};
    for (int i = 0; i < 18; ++i) a.in[i] = (const float*)d_in[i];
    a.out = (float*)d_out; a.ws = (unsigned char*)d_ws;
    void* kargs[] = {&a};
    hipError_t e = hipLaunchCooperativeKernel((const void*)mk_fwd, dim3(grid), dim3(NWAVES * 64), kargs, LDS_BYTES, stream);
    if (e != hipSuccess) fprintf(stderr, "kernel_launch: cooperative launch failed: %s (grid %d)\n", hipGetErrorString(e), grid);
}
```

```cpp
#include <hip/hip_runtime.h>
#include <hip/hip_cooperative_groups.h>
#include <cstdio>
#include <cstdint>
#include <cmath>
namespace pg8 {
#define PG8_LAS __attribute__((address_space(3)))
typedef unsigned short bf16_t;
typedef short bf16x8 __attribute__((ext_vector_type(8)));
typedef float f32x4 __attribute__((ext_vector_type(4)));
typedef unsigned u32x4 __attribute__((ext_vector_type(4)));
constexpr int BM = 256, BK = 64, HALF = 128, HTB = HALF * BK * 2  , STAGE_BYTES = 8 * HTB, NXCD = 8, WGM = 8;

__host__ __device__ __forceinline__ int lds_byte(int r, int c) { const int st = (r >> 4) * 2 + (c >> 5), rr = r & 15, cc = c & 31, ob = rr * 64 + cc * 2; return st * 1024 + (ob ^ (((ob >> 9) & 1) << 5)); }
__host__ __device__ __forceinline__ void stage_rc(int b, int& R, int& C) { const int st = b / 1024, sb = b % 1024, swz = sb ^ (((sb >> 9) & 1) << 5); R = (st >> 1) * 16 + swz / 64; C = (st & 1) * 32 + (swz % 64) / 2; }
__host__ __device__ __forceinline__ int perm32(int rho) { const int n = rho >> 4, i = rho & 15; return 8 * (i >> 2) + 4 * n + (i & 3); }

struct Unit { int pm, pn; };
struct Gemm { const bf16_t* A; const bf16_t* Bt; int M, N, K, lda, grp_tiles, grp_cols; };

struct StaticOrder {
    int nM, nN, nwg, G, c;
    __host__ __device__ void init(int M, int N, int G_, int c_) { nM = M / BM; nN = N / BM; nwg = nM * nN; G = G_; c = c_; }
    __host__ __device__ bool next(int i, Unit& u) const {
        const long L = (long)i * G + c; if (L >= nwg) return false;
        int wgid = (int)L; { const int q = nwg / NXCD, r = nwg % NXCD, xcd = wgid % NXCD, off = wgid / NXCD; wgid = (xcd < r ? xcd * (q + 1) : r * (q + 1) + (xcd - r) * q) + off; }
        const int nig = WGM * nN, gid = wgid / nig, fm = gid * WGM, gsz = (nM - fm) < WGM ? (nM - fm) : WGM;
        u.pm = fm + ((wgid % nig) % gsz); u.pn = (wgid % nig) / gsz; return true;
    }
    __device__ __forceinline__ void a_ready(const Unit&) const {}
    __device__ __forceinline__ void done(const Unit&) const {}
};

typedef float f32x2_t __attribute__((ext_vector_type(2))); typedef __bf16 bf16x2_t __attribute__((ext_vector_type(2)));
__device__ __forceinline__ unsigned cvt_pk_bf16(float lo, float hi) { f32x2_t v = {lo, hi}; bf16x2_t b = __builtin_convertvector(v, bf16x2_t); return __builtin_bit_cast(unsigned, b); }
constexpr float LOG2E = 1.4426950408889634f;
__device__ __forceinline__ float sigmoid_f(float v) { return __builtin_amdgcn_rcpf(1.0f + __builtin_amdgcn_exp2f(-v * LOG2E)); }
__device__ __forceinline__ u32x4 pack8(const f32x4 a, const f32x4 b) { u32x4 w; w.x = cvt_pk_bf16(a[0], a[1]); w.y = cvt_pk_bf16(a[2], a[3]); w.z = cvt_pk_bf16(b[0], b[1]); w.w = cvt_pk_bf16(b[2], b[3]); return w; }

struct EpiSwiGLU {
    static constexpr bool PERM = true, AFTER_DRAIN = false;
    bf16_t* O; int ldc;
    __device__ __forceinline__ void operator()(const f32x4 (&acc)[2][2][4][2], const Unit& u, int wr, int wc, int fr, int fq) const {
        const int row0 = u.pm * BM + wr * 64 + fr, col0 = u.pn * HALF + wc * 32 + 8 * fq;
#pragma unroll
        for (int ai = 0; ai < 2; ++ai)
#pragma unroll
            for (int m = 0; m < 4; ++m) { bf16_t* rowp = O + (size_t)(row0 + ai * HALF + m * 16) * ldc + col0;
                f32x4 v[2];
#pragma unroll
                for (int n = 0; n < 2; ++n) { const f32x4 g = acc[ai][0][m][n], up = acc[ai][1][m][n];
#pragma unroll
                    for (int e = 0; e < 4; ++e) v[n][e] = g[e] * sigmoid_f(g[e]) * up[e]; }
                *(u32x4*)rowp = pack8(v[0], v[1]); }
    }
};
struct EpiResF32 {
    static constexpr bool PERM = false, AFTER_DRAIN = false;
    float* X; int ldc; float scale;
    __device__ __forceinline__ void operator()(const f32x4 (&acc)[2][2][4][2], const Unit& u, int wr, int wc, int fr, int fq) const {
        const int row0 = u.pm * BM + wr * 64 + fr, col0 = u.pn * BM + wc * 32 + 4 * fq;
#pragma unroll
        for (int ai = 0; ai < 2; ++ai)
#pragma unroll
            for (int m = 0; m < 4; ++m) { float* rowp = X + (size_t)(row0 + ai * HALF + m * 16) * ldc + col0;
#pragma unroll
                for (int bj = 0; bj < 2; ++bj)
#pragma unroll
                    for (int n = 0; n < 2; ++n) { f32x4* p = (f32x4*)(rowp + bj * HALF + n * 16); *p = *p + acc[ai][bj][m][n] * scale; } }
    }
};
struct EpiQKVG {
    static constexpr bool PERM = true, AFTER_DRAIN = false;
    bf16_t* QKV; bf16_t* G; const float* bgate; float c2;
    __device__ __forceinline__ void operator()(const f32x4 (&acc)[2][2][4][2], const Unit& u, int wr, int wc, int fr, int fq) const {
        const int row0 = u.pm * BM + wr * 64 + fr;
        if (u.pn < 12) {
            const float sc = (u.pn < 2 || (u.pn >= 6 && u.pn < 8)) ? c2 : 1.0f;
            const int col0 = u.pn * BM + wc * 32 + 8 * fq;
#pragma unroll
            for (int ai = 0; ai < 2; ++ai)
#pragma unroll
                for (int m = 0; m < 4; ++m) { bf16_t* rowp = QKV + (size_t)(row0 + ai * HALF + m * 16) * 3072 + col0;
#pragma unroll
                    for (int bj = 0; bj < 2; ++bj) *(u32x4*)(rowp + bj * HALF) = pack8(acc[ai][bj][m][0] * sc, acc[ai][bj][m][1] * sc); }
        } else {
            const int col0 = (u.pn - 12) * BM + wc * 32 + 8 * fq;
            f32x4 bv[2][2];
#pragma unroll
            for (int bj = 0; bj < 2; ++bj)
#pragma unroll
                for (int n = 0; n < 2; ++n) bv[bj][n] = *(const f32x4*)(bgate + col0 + bj * HALF + 4 * n);
#pragma unroll
            for (int ai = 0; ai < 2; ++ai)
#pragma unroll
                for (int m = 0; m < 4; ++m) { bf16_t* rowp = G + (size_t)(row0 + ai * HALF + m * 16) * 2048 + col0;
#pragma unroll
                    for (int bj = 0; bj < 2; ++bj) { f32x4 v[2];
#pragma unroll
                        for (int n = 0; n < 2; ++n) { const f32x4 t = acc[ai][bj][m][n] + bv[bj][n];
#pragma unroll
                            for (int e = 0; e < 4; ++e) v[n][e] = sigmoid_f(t[e]); }
                        *(u32x4*)(rowp + bj * HALF) = pack8(v[0], v[1]); } }
        }
    }
};
struct EpiGateMul {
    static constexpr bool PERM = true, AFTER_DRAIN = false;
    bf16_t* U; const bf16_t* G; int ldc;
    __device__ __forceinline__ void operator()(const f32x4 (&acc)[2][2][4][2], const Unit& u, int wr, int wc, int fr, int fq) const {
        const int row0 = u.pm * BM + wr * 64 + fr, col0 = u.pn * BM + wc * 32 + 8 * fq;
#pragma unroll
        for (int ai = 0; ai < 2; ++ai)
#pragma unroll
            for (int m = 0; m < 4; ++m) { const size_t off = (size_t)(row0 + ai * HALF + m * 16) * ldc + col0;
#pragma unroll
                for (int bj = 0; bj < 2; ++bj) { const u32x4 gw = *(const u32x4*)(G + off + bj * HALF);
                    f32x4 g0, g1;
                    g0[0] = __uint_as_float(gw.x << 16); g0[1] = __uint_as_float(gw.x & 0xffff0000u); g0[2] = __uint_as_float(gw.y << 16); g0[3] = __uint_as_float(gw.y & 0xffff0000u);
                    g1[0] = __uint_as_float(gw.z << 16); g1[1] = __uint_as_float(gw.z & 0xffff0000u); g1[2] = __uint_as_float(gw.w << 16); g1[3] = __uint_as_float(gw.w & 0xffff0000u);
                    *(u32x4*)(U + off + bj * HALF) = pack8(acc[ai][bj][m][0] * g0, acc[ai][bj][m][1] * g1); } }
    }
};

template <class Epi, class Sched, bool ALIGN_EPI = false, bool SP2 = false>
__device__ __forceinline__ void gemm_phase(PG8_LAS unsigned char* lds, const Gemm g, const Sched& S, const Epi& E) {
    const int tid = threadIdx.x, wid = __builtin_amdgcn_readfirstlane(tid >> 6), lane = tid & 63, wr = wid >> 2, wc = wid & 3, fr = lane & 15, fq = lane >> 4;
    const int K = g.K, nt = K / BK;
    unsigned voffA[2], voffB[2];
#pragma unroll
    for (int i = 0; i < 2; ++i) { int R, C; stage_rc(tid * 16 + i * 8192, R, C); const int Rb = Epi::PERM ? ((R & ~31) + perm32(R & 31)) : R;
        voffA[i] = (unsigned)(R * g.lda + C) * 2u; voffB[i] = (unsigned)(Rb * K + C) * 2u; }
    const size_t kstep = (size_t)(BK * 2);
    const size_t hstepA = (size_t)HALF * g.lda * 2, hstepB = (size_t)HALF * K * 2;
    const size_t tstepA = 2 * hstepA, tstepB = 2 * hstepB;
    const unsigned ldsw = (unsigned)wid * 1024u;
    const int aoff = lds_byte(wr * 64 + fr, fq * 8), boff = lds_byte(wc * 32 + fr, fq * 8);
#define PG8_SA(b, h) (((b) * 2 + (h)) * HTB)
#define PG8_SB(b, h) ((4 + (b) * 2 + (h)) * HTB)
#define PG8_STAGE(bufoff, gbase, voff) do { _Pragma("unroll") for (int _i = 0; _i < 2; ++_i) \
        __builtin_amdgcn_global_load_lds((const unsigned*)((const char*)(gbase) + (voff)[_i]), (PG8_LAS unsigned*)(lds + (bufoff) + ldsw + _i * 8192), 16, 0, 0); } while (0)
#define PG8_LDA(dst, b, h) do { _Pragma("unroll") for (int m = 0; m < 4; ++m) _Pragma("unroll") for (int k = 0; k < 2; ++k) dst[m][k] = *(const PG8_LAS bf16x8*)(lds + PG8_SA(b, h) + aoff + m * 2048 + k * 1024); } while (0)
#define PG8_LDB(dst, b, h) do { _Pragma("unroll") for (int n = 0; n < 2; ++n) _Pragma("unroll") for (int k = 0; k < 2; ++k) dst[n][k] = *(const PG8_LAS bf16x8*)(lds + PG8_SB(b, h) + boff + n * 2048 + k * 1024); } while (0)
#define PG8_MMA(ai, bj, At, Bt) do { __builtin_amdgcn_s_setprio(1); _Pragma("unroll") for (int m = 0; m < 4; ++m) _Pragma("unroll") for (int n = 0; n < 2; ++n) _Pragma("unroll") for (int k = 0; k < 2; ++k) \
        acc[ai][bj][m][n] = __builtin_amdgcn_mfma_f32_16x16x32_bf16(Bt[n][k], At[m][k], acc[ai][bj][m][n], 0, 0, 0); __builtin_amdgcn_s_setprio(0); } while (0)
#define PG8_WAIT_V(n) asm volatile("s_waitcnt vmcnt(" #n ")" ::: "memory")
#define PG8_WAIT_L(n) asm volatile("s_waitcnt lgkmcnt(" #n ")" ::: "memory")
#define PG8_BAR __builtin_amdgcn_s_barrier()
#define PG8_SCHED __builtin_amdgcn_sched_barrier(0)
    Unit cur, nxt; int ui = 0;
    if (!S.next(0, cur)) return;
    f32x4 acc[2][2][4][2];
#pragma unroll
    for (int a = 0; a < 2; ++a)
#pragma unroll
        for (int b = 0; b < 2; ++b)
#pragma unroll
            for (int m = 0; m < 4; ++m)
#pragma unroll
                for (int n = 0; n < 2; ++n) acc[a][b][m][n] = (f32x4){0.f, 0.f, 0.f, 0.f};
    bf16x8 At[4][2], B0[2][2], B1[2][2];
    const char* cA = (const char*)g.A + (size_t)cur.pm * tstepA + (size_t)((cur.pn / g.grp_tiles) * g.grp_cols) * 2; const char* cB = (const char*)g.Bt + (size_t)cur.pn * tstepB;
    S.a_ready(cur);
    if constexpr (SP2) {
        PG8_STAGE(PG8_SB(0, 0), cB, voffB); PG8_STAGE(PG8_SB(0, 1), cB + hstepB, voffB); PG8_STAGE(PG8_SA(0, 0), cA, voffA); PG8_STAGE(PG8_SA(0, 1), cA + hstepA, voffA);
        if (wr == 1) PG8_BAR;
        PG8_WAIT_V(2); PG8_BAR;
        PG8_STAGE(PG8_SB(1, 0), cB + kstep, voffB); PG8_STAGE(PG8_SA(1, 0), cA + kstep, voffA); PG8_STAGE(PG8_SB(1, 1), cB + hstepB + kstep, voffB);
        PG8_WAIT_V(6); PG8_BAR;
    } else {
        PG8_STAGE(PG8_SB(0, 0), cB, voffB); PG8_STAGE(PG8_SA(0, 0), cA, voffA); PG8_STAGE(PG8_SB(0, 1), cB + hstepB, voffB); PG8_STAGE(PG8_SA(0, 1), cA + hstepA, voffA);
        if (wr == 1) PG8_BAR;
        PG8_WAIT_V(4); PG8_BAR;
        PG8_STAGE(PG8_SB(1, 0), cB + kstep, voffB); PG8_STAGE(PG8_SA(1, 0), cA + kstep, voffA); PG8_STAGE(PG8_SB(1, 1), cB + hstepB + kstep, voffB);
        PG8_WAIT_V(6); PG8_BAR;
    }
    for (;;) {
        const bool has_next = S.next(ui + 1, nxt);
        const char* nA = has_next ? (const char*)g.A + (size_t)nxt.pm * tstepA + (size_t)((nxt.pn / g.grp_tiles) * g.grp_cols) * 2 : cA; const char* nB = has_next ? (const char*)g.Bt + (size_t)nxt.pn * tstepB : cB;
        for (int t = 0; t < nt; t += 2) {
            const bool last = (t == nt - 2);
            const char* a1 = cA + (size_t)(t + 1) * kstep;
            const char* a2 = last ? nA : cA + (size_t)(t + 2) * kstep; const char* b2 = last ? nB : cB + (size_t)(t + 2) * kstep;
            const char* a3 = a2 + kstep; const char* b3 = b2 + kstep;
            if (last && has_next) S.a_ready(nxt);
            if constexpr (SP2) {
            PG8_LDB(B0, 0, 0); PG8_LDB(B1, 0, 1); PG8_SCHED; PG8_LDA(At, 0, 0); PG8_STAGE(PG8_SA(1, 1), a1 + hstepA, voffA);
            PG8_WAIT_V(8); PG8_WAIT_L(0); PG8_BAR; PG8_MMA(0, 0, At, B0); PG8_MMA(0, 1, At, B1); PG8_BAR; PG8_SCHED;
            PG8_LDA(At, 0, 1); PG8_STAGE(PG8_SB(0, 0), b2, voffB); PG8_STAGE(PG8_SB(0, 1), b2 + hstepB, voffB); PG8_STAGE(PG8_SA(0, 0), a2, voffA);
            PG8_WAIT_V(8); PG8_WAIT_L(0); PG8_BAR; PG8_MMA(1, 0, At, B0); PG8_MMA(1, 1, At, B1); PG8_BAR; PG8_SCHED;
            PG8_LDB(B0, 1, 0); PG8_LDB(B1, 1, 1); PG8_SCHED; PG8_LDA(At, 1, 0); PG8_STAGE(PG8_SA(0, 1), a2 + hstepA, voffA);
            PG8_WAIT_V(8); PG8_WAIT_L(0); PG8_BAR; PG8_MMA(0, 0, At, B0); PG8_MMA(0, 1, At, B1); PG8_BAR; PG8_SCHED;
            PG8_LDA(At, 1, 1); PG8_STAGE(PG8_SB(1, 0), b3, voffB); PG8_STAGE(PG8_SB(1, 1), b3 + hstepB, voffB); PG8_STAGE(PG8_SA(1, 0), a3, voffA);
            PG8_WAIT_V(8); PG8_WAIT_L(0); PG8_BAR; PG8_MMA(1, 0, At, B0); PG8_MMA(1, 1, At, B1); PG8_BAR; PG8_SCHED;
            } else {
            PG8_LDB(B0, 0, 0); PG8_SCHED; PG8_LDA(At, 0, 0); PG8_STAGE(PG8_SA(1, 1), a1 + hstepA, voffA);
            PG8_WAIT_L(8); PG8_BAR; PG8_WAIT_L(0); PG8_MMA(0, 0, At, B0); PG8_BAR; PG8_SCHED;
            PG8_LDB(B1, 0, 1); PG8_STAGE(PG8_SB(0, 0), b2, voffB);
            PG8_BAR; PG8_WAIT_L(0); PG8_MMA(0, 1, At, B1); PG8_BAR;
            PG8_LDA(At, 0, 1); PG8_STAGE(PG8_SA(0, 0), a2, voffA);
            PG8_BAR; PG8_WAIT_L(0); PG8_MMA(1, 0, At, B0); PG8_BAR; PG8_SCHED;
            PG8_STAGE(PG8_SB(0, 1), b2 + hstepB, voffB);
            PG8_WAIT_V(6); PG8_BAR; PG8_MMA(1, 1, At, B1); PG8_BAR;
            PG8_LDB(B0, 1, 0); PG8_SCHED; PG8_LDA(At, 1, 0); PG8_STAGE(PG8_SA(0, 1), a2 + hstepA, voffA);
            PG8_WAIT_L(8); PG8_BAR; PG8_WAIT_L(0); PG8_MMA(0, 0, At, B0); PG8_BAR; PG8_SCHED;
            PG8_LDB(B1, 1, 1); PG8_STAGE(PG8_SB(1, 0), b3, voffB);
            PG8_BAR; PG8_WAIT_L(0); PG8_MMA(0, 1, At, B1); PG8_BAR;
            PG8_LDA(At, 1, 1); PG8_STAGE(PG8_SA(1, 0), a3, voffA);
            PG8_BAR; PG8_WAIT_L(0); PG8_MMA(1, 0, At, B0); PG8_BAR; PG8_SCHED;
            PG8_STAGE(PG8_SB(1, 1), b3 + hstepB, voffB);
            PG8_WAIT_V(6); PG8_BAR; PG8_MMA(1, 1, At, B1); PG8_BAR;
            }
        }
        if constexpr (ALIGN_EPI) { if (wr == 0) PG8_BAR; }
        if constexpr (!Epi::AFTER_DRAIN) { E(acc, cur, wr, wc, fr, fq); S.done(cur); }
        if (!has_next) break;
#pragma unroll
        for (int a = 0; a < 2; ++a)
#pragma unroll
            for (int b = 0; b < 2; ++b)
#pragma unroll
                for (int m = 0; m < 4; ++m)
#pragma unroll
                    for (int n = 0; n < 2; ++n) acc[a][b][m][n] = (f32x4){0.f, 0.f, 0.f, 0.f};
        cur = nxt; cA = nA; cB = nB; ++ui;
        if constexpr (ALIGN_EPI) { if (wr == 1) PG8_BAR; }
    }
    PG8_WAIT_V(0);
    if constexpr (!ALIGN_EPI) { if (wr == 0) PG8_BAR; }
    PG8_BAR;
    if constexpr (Epi::AFTER_DRAIN) { E.fused(acc, cur, wr, wc, fr, fq, lds, wid, lane); S.done(cur); }
#undef PG8_SA
#undef PG8_SB
#undef PG8_STAGE
#undef PG8_LDA
#undef PG8_LDB
#undef PG8_MMA
#undef PG8_WAIT_V
#undef PG8_WAIT_L
#undef PG8_BAR
#undef PG8_SCHED
}
}
namespace att {
#define ALAS __attribute__((address_space(3)))
typedef unsigned short bf16_t;
typedef short bf16x8 __attribute__((ext_vector_type(8)));
typedef short s16x4 __attribute__((ext_vector_type(4)));
typedef float f32x16 __attribute__((ext_vector_type(16)));
typedef float f32x4 __attribute__((ext_vector_type(4)));
typedef unsigned u32x4 __attribute__((ext_vector_type(4)));
typedef unsigned u32x2 __attribute__((ext_vector_type(2)));
constexpr int SEQ = 2048, QP = 3072, YP = 1024;
constexpr int KBUF = 0, VBUF = 16384, LFC_OFF = 32768, RED_OFF = 40960, ATT_LDS = 41216;
typedef float f32x2_t __attribute__((ext_vector_type(2))); typedef __bf16 bf16x2_t __attribute__((ext_vector_type(2)));
__device__ __forceinline__ unsigned cvtpk(float lo, float hi) { f32x2_t v = {lo, hi}; bf16x2_t b = __builtin_convertvector(v, bf16x2_t); return __builtin_bit_cast(unsigned, b); }
__device__ __forceinline__ s16x4 vtr(const ALAS unsigned char* p) { return __builtin_bit_cast(s16x4, __builtin_amdgcn_ds_read_tr16_b64_v4i16((ALAS s16x4*)p)); }
__device__ __forceinline__ float halfswap_max(float v) { auto rr = __builtin_amdgcn_permlane32_swap(__float_as_uint(v), __float_as_uint(v), false, false); return fmaxf(__uint_as_float(rr[0]), __uint_as_float(rr[1])); }
__device__ __forceinline__ float halfswap_sum(float v) { auto rr = __builtin_amdgcn_permlane32_swap(__float_as_uint(v), __float_as_uint(v), false, false); return __uint_as_float(rr[0]) + __uint_as_float(rr[1]); }

template <int MODE>
__device__ __forceinline__ void attn_unit(int b, int h, int qb, const bf16_t* __restrict__ QKV, bf16_t* __restrict__ Y, ALAS unsigned char* lds) {
    const int tid = threadIdx.x, lane = tid & 63, r32 = lane & 31, hi = lane >> 5, wid = __builtin_amdgcn_readfirstlane(tid >> 6);
    const int q0 = qb * 256, qw = q0 + 32 * wid, q = qw + r32;
    const size_t rowbase = (size_t)b * SEQ;
    const int colq = (MODE ? 1536 : 0) + h * 64, colk = colq + 512, colv = colq + 1024;
    bf16x8 qr[4];
    { const bf16_t* Qp = QKV + (rowbase + q) * QP + colq + hi * 8;
#pragma unroll
      for (int d0 = 0; d0 < 4; ++d0) qr[d0] = *(const bf16x8*)(Qp + d0 * 16); }
    const bf16_t* ksrc = QKV + (rowbase + lane) * QP + colk + wid * 8;
    const bf16_t* vsrc = QKV + (rowbase + 16 * (wid & 3) + (lane >> 2)) * QP + colv + (wid >> 2) * 32 + (lane & 3) * 8;
    const int sto = wid * 1024 + lane * 16;
    const int NT = (q0 + 256) / 64;
    const int koff = hi * 1024 + r32 * 16;
    const int voff = ((lane >> 4) & 1) * 32 + (lane & 3) * 8 + (4 * hi + ((lane & 15) >> 2)) * 64;
    f32x16 o0, o1;
#pragma unroll
    for (int r = 0; r < 16; ++r) { o0[r] = 0.f; o1[r] = 0.f; }
    float m_run = -1e30f, l_run = 0.f, carry = 0.f;
    { const int t0 = MODE ? 0 : NT - 1;
      const u32x4 kr = *(const u32x4*)(ksrc + (size_t)t0 * 64 * QP), vr = *(const u32x4*)(vsrc + (size_t)t0 * 64 * QP);
      *(ALAS u32x4*)(lds + KBUF + sto) = kr; *(ALAS u32x4*)(lds + VBUF + sto) = vr; }
    __syncthreads();
    for (int i = 0; i < NT; ++i) {
        const int t = MODE ? i : NT - 1 - i, tn = MODE ? t + 1 : t - 1;
        const bool more = (i + 1 < NT);
        u32x4 kr = {0u, 0u, 0u, 0u}, vr = {0u, 0u, 0u, 0u};
        if (more) { kr = *(const u32x4*)(ksrc + (size_t)tn * 64 * QP); vr = *(const u32x4*)(vsrc + (size_t)tn * 64 * QP); }
        const int bo = (i & 1) * 8192;
        if (64 * t <= qw + 31) {
            f32x16 p0, p1;
#pragma unroll
            for (int r = 0; r < 16; ++r) { p0[r] = 0.f; p1[r] = 0.f; }
#pragma unroll
            for (int d0 = 0; d0 < 4; ++d0) {
                const bf16x8 k0 = *(const ALAS bf16x8*)(lds + KBUF + bo + koff + d0 * 2048);
                const bf16x8 k1 = *(const ALAS bf16x8*)(lds + KBUF + bo + koff + d0 * 2048 + 512);
                p0 = __builtin_amdgcn_mfma_f32_32x32x16_bf16(k0, qr[d0], p0, 0, 0, 0);
                p1 = __builtin_amdgcn_mfma_f32_32x32x16_bf16(k1, qr[d0], p1, 0, 0, 0);
            }
            const int kv0 = 64 * t + 4 * hi;
            const bool diag = (64 * t + 63 >= qw);
            if (MODE == 1) {
#pragma unroll
                for (int g4 = 0; g4 < 4; ++g4) {
                    const f32x4 b0 = *(const ALAS f32x4*)(lds + LFC_OFF + (kv0 + 8 * g4) * 4), b1 = *(const ALAS f32x4*)(lds + LFC_OFF + (kv0 + 32 + 8 * g4) * 4);
#pragma unroll
                    for (int e = 0; e < 4; ++e) { p0[4 * g4 + e] += b0[e]; p1[4 * g4 + e] += b1[e]; }
                }
                if (diag) {
#pragma unroll
                    for (int r = 0; r < 16; ++r) { const int kv = kv0 + (r & 3) + 8 * (r >> 2); if (kv > q) p0[r] = -INFINITY; if (kv + 32 > q) p1[r] = -INFINITY; }
                }
                float mx = fmaxf(p0[0], p1[0]);
#pragma unroll
                for (int r = 1; r < 16; ++r) mx = fmaxf(mx, fmaxf(p0[r], p1[r]));
                mx = halfswap_max(mx);
                const float m_new = fmaxf(m_run, mx), f = __builtin_amdgcn_exp2f(m_run - m_new);
                m_run = m_new;
                float rs = 0.f;
#pragma unroll
                for (int r = 0; r < 16; ++r) { p0[r] = __builtin_amdgcn_exp2f(p0[r] - m_new); p1[r] = __builtin_amdgcn_exp2f(p1[r] - m_new); rs += p0[r] + p1[r]; }
                l_run = l_run * f + rs;
#pragma unroll
                for (int r = 0; r < 16; ++r) { o0[r] *= f; o1[r] *= f; }
            } else {
                f32x16 n0, n1;
#pragma unroll
                for (int r = 0; r < 16; ++r) {
                    { const float z = p0[r], lab = __builtin_amdgcn_logf(1.0f + __builtin_amdgcn_exp2f(-fabsf(z))), L = fminf(z, 0.f) - lab; p0[r] = L; n0[r] = L - z; }
                    { const float z = p1[r], lab = __builtin_amdgcn_logf(1.0f + __builtin_amdgcn_exp2f(-fabsf(z))), L = fminf(z, 0.f) - lab; p1[r] = L; n1[r] = L - z; }
                }
                if (diag) {
#pragma unroll
                    for (int r = 0; r < 16; ++r) { const int kv = kv0 + (r & 3) + 8 * (r >> 2);
                        if (kv >= q) { p0[r] = -INFINITY; n0[r] = 0.f; } if (kv + 32 >= q) { p1[r] = -INFINITY; n1[r] = 0.f; } }
                }
                float T[8], X[8];
#pragma unroll
                for (int k = 0; k < 8; ++k) {
                    const float gsum = (k < 4) ? ((n0[4 * k] + n0[4 * k + 1]) + (n0[4 * k + 2] + n0[4 * k + 3])) : ((n1[4 * (k - 4)] + n1[4 * (k - 4) + 1]) + (n1[4 * (k - 4) + 2] + n1[4 * (k - 4) + 3]));
                    auto rr = __builtin_amdgcn_permlane32_swap(__float_as_uint(gsum), __float_as_uint(gsum), false, false);
                    const float vlo = __uint_as_float(rr[0]), vhi = __uint_as_float(rr[1]);
                    T[k] = vlo + vhi; X[k] = hi ? 0.f : vhi;
                }
                float suf = carry;
#pragma unroll
                for (int k = 7; k >= 0; --k) {
                    const float base = suf + X[k];
                    if (k < 4) { const int r = 4 * k; const float b3 = base, b2 = b3 + n0[r + 3], b1 = b2 + n0[r + 2], b0 = b1 + n0[r + 1];
                        p0[r] = __builtin_amdgcn_exp2f(p0[r] + b0); p0[r + 1] = __builtin_amdgcn_exp2f(p0[r + 1] + b1); p0[r + 2] = __builtin_amdgcn_exp2f(p0[r + 2] + b2); p0[r + 3] = __builtin_amdgcn_exp2f(p0[r + 3] + b3); }
                    else { const int r = 4 * (k - 4); const float b3 = base, b2 = b3 + n1[r + 3], b1 = b2 + n1[r + 2], b0 = b1 + n1[r + 1];
                        p1[r] = __builtin_amdgcn_exp2f(p1[r] + b0); p1[r + 1] = __builtin_amdgcn_exp2f(p1[r + 1] + b1); p1[r + 2] = __builtin_amdgcn_exp2f(p1[r + 2] + b2); p1[r + 3] = __builtin_amdgcn_exp2f(p1[r + 3] + b3); }
                    suf += T[k];
                }
                carry = suf;
            }
            bf16x8 pw[4];
#pragma unroll
            for (int ks = 0; ks < 4; ++ks) { const int r = 8 * (ks & 1); u32x4 w;
                if (ks < 2) { w.x = cvtpk(p0[r], p0[r + 1]); w.y = cvtpk(p0[r + 2], p0[r + 3]); w.z = cvtpk(p0[r + 4], p0[r + 5]); w.w = cvtpk(p0[r + 6], p0[r + 7]); }
                else        { w.x = cvtpk(p1[r], p1[r + 1]); w.y = cvtpk(p1[r + 2], p1[r + 3]); w.z = cvtpk(p1[r + 4], p1[r + 5]); w.w = cvtpk(p1[r + 6], p1[r + 7]); }
                pw[ks] = __builtin_bit_cast(bf16x8, w); }
#pragma unroll
            for (int ks = 0; ks < 4; ++ks) {
                const ALAS unsigned char* vp = lds + VBUF + bo + voff + ks * 1024;
                const s16x4 a0 = vtr(vp), a1 = vtr(vp + 512), c0 = vtr(vp + 4096), c1 = vtr(vp + 4096 + 512);
                const bf16x8 vf0 = {a0[0], a0[1], a0[2], a0[3], a1[0], a1[1], a1[2], a1[3]}, vf1 = {c0[0], c0[1], c0[2], c0[3], c1[0], c1[1], c1[2], c1[3]};
                o0 = __builtin_amdgcn_mfma_f32_32x32x16_bf16(vf0, pw[ks], o0, 0, 0, 0);
                o1 = __builtin_amdgcn_mfma_f32_32x32x16_bf16(vf1, pw[ks], o1, 0, 0, 0);
            }
        }
        if (more) { const int bn = ((i + 1) & 1) * 8192; *(ALAS u32x4*)(lds + KBUF + bn + sto) = kr; *(ALAS u32x4*)(lds + VBUF + bn + sto) = vr; }
        __syncthreads();
    }
    float inv = 1.0f;
    if (MODE == 1) { const float lt = halfswap_sum(l_run); inv = 1.0f / lt; }
    bf16_t* Yp = Y + (rowbase + q) * YP + (MODE ? 512 : 0) + h * 64 + 4 * hi;
#pragma unroll
    for (int g4 = 0; g4 < 4; ++g4) {
        u32x2 w0, w1;
        w0.x = cvtpk(o0[4 * g4] * inv, o0[4 * g4 + 1] * inv); w0.y = cvtpk(o0[4 * g4 + 2] * inv, o0[4 * g4 + 3] * inv);
        w1.x = cvtpk(o1[4 * g4] * inv, o1[4 * g4 + 1] * inv); w1.y = cvtpk(o1[4 * g4 + 2] * inv, o1[4 * g4 + 3] * inv);
        *(u32x2*)(Yp + 8 * g4) = w0; *(u32x2*)(Yp + 32 + 8 * g4) = w1;
    }
}
__device__ __forceinline__ void fox_bias_scan(const float* __restrict__ LF, int bh, ALAS unsigned char* lds) {
    const int tid = threadIdx.x, lane = tid & 63, wid = tid >> 6;
    const f32x4 v = *(const f32x4*)(LF + (size_t)bh * SEQ + 4 * tid);
    const float s1 = v[0], s2 = s1 + v[1], s3 = s2 + v[2], s4 = s3 + v[3];
    float inc = s4;
#pragma unroll
    for (int o = 1; o < 64; o <<= 1) { const float up = __shfl_up(inc, o); if (lane >= o) inc += up; }
    ALAS float* red = (ALAS float*)(lds + RED_OFF);
    if (lane == 63) red[wid] = inc;
    __syncthreads();
    float woff = 0.f;
    for (int w = 0; w < wid; ++w) woff += red[w];
    const float ex = woff + inc - s4;
    const float c = -1.4426950408889634f;
    f32x4 o; o[0] = c * (ex + s1); o[1] = c * (ex + s2); o[2] = c * (ex + s3); o[3] = c * (ex + s4);
    *(ALAS f32x4*)(lds + LFC_OFF + 16 * tid) = o;
    __syncthreads();
}
}
namespace cg = cooperative_groups;
constexpr int NWAVES = 8;
constexpr int BATCH = 8, SEQ = 2048, D = 1024, FF = 2816, M = BATCH * SEQ, INC = 3080;
constexpr float RMS_EPS = 1e-6f;
constexpr float C2 = 0.125f * 1.4426950408889634f;
constexpr size_t MiB = 1u << 20;
constexpr size_t WS_LF = 1 * MiB;
constexpr size_t WS_W1GU = 2 * MiB, WS_W1D = 13 * MiB, WS_W2GU = 19 * MiB, WS_W2D = 30 * MiB, WS_WQKVG = 36 * MiB, WS_WUP = 46 * MiB, WS_WOUT = 48 * MiB;
constexpr size_t WS_XN = 52 * MiB;
constexpr size_t WS_BIG = 84 * MiB;
constexpr size_t WS_GATES = 180 * MiB;
constexpr size_t WS_END = 244 * MiB;
constexpr int LDS_BYTES = 147456;

typedef unsigned short bf16;
typedef unsigned v4u __attribute__((ext_vector_type(4)));
typedef float f32x4 __attribute__((ext_vector_type(4)));
#define LAS __attribute__((address_space(3)))
#define LDS_WAIT() asm volatile("s_waitcnt lgkmcnt(0)" ::: "memory")
__device__ __forceinline__ unsigned pk2(float lo, float hi) { return pg8::cvt_pk_bf16(lo, hi); }
__device__ __forceinline__ float wave_sum(float v) {
#pragma unroll
    for (int o = 1; o < 64; o <<= 1) v += __shfl_xor(v, o);
    return v;
}
__device__ __forceinline__ void transpose_item(const float* __restrict__ W, int ldw, int k0, int n0, bf16* __restrict__ WT, int ldt, int drow0, int dk0, LAS float* scr, int lane) {
#pragma unroll 8
    for (int i = 0; i < 32; ++i) { const int kk = 2 * i + (lane >> 5); scr[kk * 33 + (lane & 31)] = W[(size_t)(k0 + kk) * ldw + n0 + (lane & 31)]; }
    LDS_WAIT(); asm volatile("" ::: "memory");
    const int c = lane & 7;
#pragma unroll
    for (int j = 0; j < 4; ++j) { const int n = (lane >> 3) + 8 * j; const LAS float* s = scr + (8 * c) * 33 + n;
        v4u o; o.x = pk2(s[0 * 33], s[1 * 33]); o.y = pk2(s[2 * 33], s[3 * 33]); o.z = pk2(s[4 * 33], s[5 * 33]); o.w = pk2(s[6 * 33], s[7 * 33]);
        *(v4u*)(WT + (size_t)(drow0 + n) * ldt + dk0 + k0 + 8 * c) = o; }
    LDS_WAIT(); asm volatile("" ::: "memory");
}
#define XB_TMO      128
#define XB_XCNT(j)  (256  + 64 * (j))
#define XB_XSUB(j)  (1280 + 64 * (j))
#define XB_XGEN(j)  (2304 + 64 * (j))
#define XB_TOP      3328
#define XB_TOPGEN   3392
#define XCD_BAR_WORDS 3456
#define XB_SPIN_CAP (1u << 18)

__device__ __forceinline__ unsigned xb_ld(unsigned* p)              { return __hip_atomic_load(p, __ATOMIC_RELAXED, __HIP_MEMORY_SCOPE_AGENT); }
__device__ __forceinline__ unsigned xb_add(unsigned* p, unsigned v) { return __hip_atomic_fetch_add(p, v, __ATOMIC_RELAXED, __HIP_MEMORY_SCOPE_AGENT); }
__device__ __forceinline__ unsigned xb_xcc_id() { return (unsigned)__builtin_amdgcn_s_getreg((3 << 11) | 20) & 0xFu; }
#define XB_SPIN(cond, bar) do { unsigned _sp = 0; while (cond) { __builtin_amdgcn_s_sleep(1); \
    if ((++_sp & 255u) == 0u) { if (xb_ld(&(bar)[XB_TMO])) break; if (_sp > XB_SPIN_CAP) { atomicAdd(&(bar)[XB_TMO], 1u); break; } } } } while (0)

struct XcdBarrier {
    unsigned* bar; unsigned x;
    volatile LAS unsigned* st;
};

__device__ __forceinline__ XcdBarrier xcd_barrier_post(unsigned* bar, volatile LAS unsigned* st) {
    XcdBarrier b; b.bar = bar; b.x = xb_xcc_id(); b.st = st;
    if (threadIdx.x == 0) (void)xb_add(&bar[XB_XCNT(b.x)], 1u);
    return b;
}
__device__ __forceinline__ void xcd_barrier_complete(unsigned* bar, unsigned x, unsigned& nloc, unsigned& nx) {
    const unsigned G = gridDim.x * gridDim.y * gridDim.z;
    unsigned sum, cnt, mine, sp = 0u;
    for (;;) {
        sum = 0u; cnt = 0u; mine = 0u;
#pragma unroll
        for (unsigned j = 0; j < 16; ++j) { const unsigned c = xb_ld(&bar[XB_XCNT(j)]); sum += c; cnt += (c > 0u) ? 1u : 0u; mine = (j == x) ? c : mine; }
        if (sum == G) break;
        __builtin_amdgcn_s_sleep(1);
        if ((++sp & 255u) == 0u) { if (xb_ld(&bar[XB_TMO])) break; if (sp > XB_SPIN_CAP) { atomicAdd(&bar[XB_TMO], 1u); break; } }
    }
    nloc = mine > 0u ? mine : 1u; nx = cnt > 0u ? cnt : 1u;
}

__device__ __forceinline__ void xcd_barrier(const XcdBarrier& b) {
    asm volatile("s_waitcnt vmcnt(0)" ::: "memory");
    __syncthreads();
    if (threadIdx.x == 0) {
        unsigned* bar = b.bar;
        __builtin_amdgcn_s_waitcnt(0);
        unsigned nloc = b.st[0], nx = b.st[1];
        if (nloc == 0u) { xcd_barrier_complete(bar, b.x, nloc, nx); b.st[0] = nloc; b.st[1] = nx; }
        const unsigned old = xb_add(&bar[XB_XSUB(b.x)], 1u);
        const unsigned gen = old / nloc;
        if (old + 1u == (gen + 1u) * nloc) {
            __builtin_amdgcn_fence(__ATOMIC_RELEASE, "agent");
            asm volatile("s_waitcnt vmcnt(0)" ::: "memory");
            const unsigned og = xb_add(&bar[XB_TOP], 1u);
            const unsigned tg = og / nx;
            if (og + 1u == (tg + 1u) * nx) xb_add(&bar[XB_TOPGEN], 1u);
            else XB_SPIN(xb_ld(&bar[XB_TOPGEN]) == tg, bar);
            __builtin_amdgcn_fence(__ATOMIC_ACQUIRE, "agent");
            xb_add(&bar[XB_XGEN(b.x)], 1u);
            asm volatile("s_waitcnt vmcnt(0)" ::: "memory");
        } else {
            XB_SPIN(xb_ld(&bar[XB_XGEN(b.x)]) == gen, bar);
            __builtin_amdgcn_fence(__ATOMIC_ACQUIRE, "agent");
            asm volatile("s_waitcnt vmcnt(0)" ::: "memory");
        }
    }
    __syncthreads();
}

struct Args { const float* in[18]; float* out; unsigned char* ws; int use_cg, pad; };
struct WItem { const float* W; int ldw, ncols32, K; bf16* WT; int ldt, mode, dk0; };
__device__ __forceinline__ void conv_matrix(const float* W, int ldw, int ncols, int K, bf16* WT, int ldt, int mode, int rowadd, int dk0, int& it, int gw, int NGW, LAS float* scr, int lane) {
    const int nb32 = ncols / 32, nitems = (K / 64) * nb32;
    int first = it + ((gw - it) % NGW + NGW) % NGW;
    for (int g = first; g < it + nitems; g += NGW) {
        const int r = g - it, kb = r / nb32, nb = r % nb32, k0 = 64 * kb, n0 = 32 * nb;
        int drow0 = n0 + rowadd;
        if (mode == 1) drow0 = 256 * (n0 / 128) + (n0 % 128);
        else if (mode == 2) drow0 = 256 * (n0 / 128) + 128 + (n0 % 128);
        transpose_item(W, ldw, k0, n0, WT, ldt, drow0, dk0, scr, lane);
    }
    it += nitems;
}
__device__ __forceinline__ void rms_row(const float* xrow, const f32x4 (&g)[4], f32x4 (&v)[4], int lane) {
    const f32x4* xr = (const f32x4*)xrow + lane; float s2 = 0.f;
#pragma unroll
    for (int j = 0; j < 4; ++j) { v[j] = xr[64 * j]; s2 += (v[j].x * v[j].x + v[j].y * v[j].y) + (v[j].z * v[j].z + v[j].w * v[j].w); }
    const float rstd = 1.0f / sqrtf(wave_sum(s2) * (1.0f / D) + RMS_EPS);
#pragma unroll
    for (int j = 0; j < 4; ++j) v[j] = v[j] * rstd * g[j];
}
__device__ __forceinline__ void store_row_bf16(bf16* orow, const f32x4 (&v)[4], int lane) {
    unsigned long long* o8 = (unsigned long long*)orow + lane;
#pragma unroll
    for (int j = 0; j < 4; ++j) o8[64 * j] = (unsigned long long)pk2(v[j].x, v[j].y) | ((unsigned long long)pk2(v[j].z, v[j].w) << 32);
}
__device__ __forceinline__ void norm_phase_bf16(const float* X, const float* gain, bf16* XN, int gw, int NGW, int lane) {
    f32x4 g[4];
#pragma unroll
    for (int j = 0; j < 4; ++j) g[j] = ((const f32x4*)gain)[lane + 64 * j];
    for (int m = gw; m < M; m += NGW) { f32x4 v[4]; rms_row(X + (size_t)m * D, g, v, lane); store_row_bf16(XN + (size_t)m * D, v, lane); }
}

#define GRID_SYNC() xcd_barrier(bar)
__global__ void __launch_bounds__(NWAVES * 64, 2) mk_fwd(Args args) {
    extern __shared__ __attribute__((aligned(16))) unsigned char lds_raw[];
    LAS unsigned char* lds = (LAS unsigned char*)lds_raw;
    if (args.use_cg) { cg::grid_group grid = cg::this_grid(); grid.sync(); }
    const int tid = threadIdx.x, lane = tid & 63, wave = __builtin_amdgcn_readfirstlane(tid >> 6);
    const int G = gridDim.x, bx = blockIdx.x;
    const int vcu = (G % 8 == 0) ? (bx % 8) * (G / 8) + bx / 8 : bx;
    const int gw = vcu * NWAVES + wave, NGW = G * NWAVES;
    unsigned char* ws = args.ws;
    const float* x = args.in[0];
    float* X = args.out;
    bf16* W1GU = (bf16*)(ws + WS_W1GU); bf16* W1D = (bf16*)(ws + WS_W1D); bf16* W2GU = (bf16*)(ws + WS_W2GU); bf16* W2D = (bf16*)(ws + WS_W2D);
    bf16* WQKVG = (bf16*)(ws + WS_WQKVG); bf16* WUP = (bf16*)(ws + WS_WUP); bf16* WOUT = (bf16*)(ws + WS_WOUT);
    bf16* XN = (bf16*)(ws + WS_XN); bf16* BIG = (bf16*)(ws + WS_BIG); bf16* GATES = (bf16*)(ws + WS_GATES);
    float* LF = (float*)(ws + WS_LF);
    volatile LAS unsigned* misc = (volatile LAS unsigned*)(lds + 131072 + 1024);
    if (tid < 2) misc[tid] = 0u;
    __syncthreads();
    XcdBarrier bar = xcd_barrier_post((unsigned*)ws, misc);

    {
        LAS float* scr = (LAS float*)(lds + wave * 16384);
        int it = 0;
        conv_matrix(args.in[2], FF, FF, D, W1GU, D, 1, 0, 0, it, gw, NGW, scr, lane);
        conv_matrix(args.in[3], FF, FF, D, W1GU, D, 2, 0, 0, it, gw, NGW, scr, lane);
        conv_matrix(args.in[4], D, D, FF, W1D, FF, 0, 0, 0, it, gw, NGW, scr, lane);
        conv_matrix(args.in[14], FF, FF, D, W2GU, D, 1, 0, 0, it, gw, NGW, scr, lane);
        conv_matrix(args.in[15], FF, FF, D, W2GU, D, 2, 0, 0, it, gw, NGW, scr, lane);
        conv_matrix(args.in[16], D, D, FF, W2D, FF, 0, 0, 0, it, gw, NGW, scr, lane);
        conv_matrix(args.in[6], INC, 3072, D, WQKVG, D, 0, 0, 0, it, gw, NGW, scr, lane);
        conv_matrix(args.in[8], 2048, 2048, D, WQKVG, D, 0, 3072, 0, it, gw, NGW, scr, lane);
        conv_matrix(args.in[10], D, D, 512, WUP, 512, 0, 0, 0, it, gw, NGW, scr, lane);
        conv_matrix(args.in[11], D, D, 512, WUP, 512, 0, 1024, 0, it, gw, NGW, scr, lane);
        conv_matrix(args.in[12], D, D, D, WOUT, 2048, 0, 0, 0, it, gw, NGW, scr, lane);
        conv_matrix(args.in[12], D, D, D, WOUT, 2048, 0, 0, 1024, it, gw, NGW, scr, lane);
        f32x4 g[4];
#pragma unroll
        for (int j = 0; j < 4; ++j) g[j] = ((const f32x4*)args.in[1])[lane + 64 * j];
        for (int m = gw; m < M; m += NGW) {
            const f32x4* xr = (const f32x4*)(x + (size_t)m * D) + lane; f32x4* xo = (f32x4*)(X + (size_t)m * D) + lane;
#pragma unroll
            for (int j = 0; j < 4; ++j) xo[64 * j] = xr[64 * j];
            f32x4 v[4]; rms_row(x + (size_t)m * D, g, v, lane); store_row_bf16(XN + (size_t)m * D, v, lane);
        }
    }
    GRID_SYNC();
    { pg8::Gemm g{XN, W1GU, M, 2 * FF, D, D, 1 << 20, 0}; pg8::StaticOrder S; S.init(M, 2 * FF, G, bx);
      pg8::EpiSwiGLU E{BIG, FF};
      pg8::gemm_phase<pg8::EpiSwiGLU, pg8::StaticOrder, true, true>(lds, g, S, E); }
    GRID_SYNC();
    { pg8::Gemm g{BIG, W1D, M, D, FF, FF, 1 << 20, 0}; pg8::StaticOrder S; S.init(M, D, G, bx);
      pg8::EpiResF32 E{X, D, 0.5f};
      pg8::gemm_phase<pg8::EpiResF32, pg8::StaticOrder, true, true>(lds, g, S, E); }
    GRID_SYNC();
    {
        f32x4 g[4];
#pragma unroll
        for (int j = 0; j < 4; ++j) g[j] = ((const f32x4*)args.in[5])[lane + 64 * j];
        const float* w_in = args.in[6];
        f32x4 wf[4][4][2];
#pragma unroll
        for (int j = 0; j < 4; ++j)
#pragma unroll
            for (int e = 0; e < 4; ++e) { const float* p = w_in + (size_t)(256 * j + 4 * lane + e) * INC + 3072; wf[j][e][0] = *(const f32x4*)p; wf[j][e][1] = *(const f32x4*)(p + 4); }
        const float bfg = args.in[7][lane & 7];
        for (int m = gw; m < M; m += NGW) {
            f32x4 v[4]; rms_row(X + (size_t)m * D, g, v, lane); store_row_bf16(XN + (size_t)m * D, v, lane);
            f32x4 a0 = {0.f, 0.f, 0.f, 0.f}, a1 = {0.f, 0.f, 0.f, 0.f};
#pragma unroll
            for (int j = 0; j < 4; ++j)
#pragma unroll
                for (int e = 0; e < 4; ++e) { a0 += wf[j][e][0] * v[j][e]; a1 += wf[j][e][1] * v[j][e]; }
            float fl[8] = {a0[0], a0[1], a0[2], a0[3], a1[0], a1[1], a1[2], a1[3]};
#pragma unroll
            for (int c = 0; c < 8; ++c) fl[c] = wave_sum(fl[c]);
            float mine = fl[0];
#pragma unroll
            for (int c = 1; c < 8; ++c) mine = ((lane & 7) == c) ? fl[c] : mine;
            if (lane < 8) { const float t = mine + bfg; const float ls = fminf(t, 0.f) - log1pf(expf(-fabsf(t)));
                LF[(size_t)((m / SEQ) * 8 + lane) * SEQ + (m % SEQ)] = ls; }
        }
    }
    GRID_SYNC();
    { pg8::Gemm g{XN, WQKVG, M, 5120, D, D, 1 << 20, 0}; pg8::StaticOrder S; S.init(M, 5120, G, bx);
      pg8::EpiQKVG E{BIG, GATES, args.in[9], C2};
      pg8::gemm_phase<pg8::EpiQKVG, pg8::StaticOrder, true, true>(lds, g, S, E); }
    GRID_SYNC();
    for (int pi = vcu; pi < 256; pi += G) {
        const int bh = pi >> 2, s = pi & 3, b = bh >> 3, h = bh & 7;
        att::attn_unit<0>(b, h, 7 - s, BIG, XN, lds);
        att::attn_unit<0>(b, h, s, BIG, XN, lds);
        att::fox_bias_scan(LF, bh, lds);
        att::attn_unit<1>(b, h, 7 - s, BIG, XN, lds);
        att::attn_unit<1>(b, h, s, BIG, XN, lds);
    }
    GRID_SYNC();
    { pg8::Gemm g{XN, WUP, M, 2048, 512, 1024, 4, 512}; pg8::StaticOrder S; S.init(M, 2048, G, bx);
      pg8::EpiGateMul E{BIG, GATES, 2048};
      pg8::gemm_phase<pg8::EpiGateMul, pg8::StaticOrder, true, true>(lds, g, S, E); }
    GRID_SYNC();
    { pg8::Gemm g{BIG, WOUT, M, D, 2048, 2048, 1 << 20, 0}; pg8::StaticOrder S; S.init(M, D, G, bx);
      pg8::EpiResF32 E{X, D, 1.0f};
      pg8::gemm_phase<pg8::EpiResF32, pg8::StaticOrder, true, true>(lds, g, S, E); }
    GRID_SYNC();
    norm_phase_bf16(X, args.in[13], XN, gw, NGW, lane);
    GRID_SYNC();
    { pg8::Gemm g{XN, W2GU, M, 2 * FF, D, D, 1 << 20, 0}; pg8::StaticOrder S; S.init(M, 2 * FF, G, bx);
      pg8::EpiSwiGLU E{BIG, FF};
      pg8::gemm_phase<pg8::EpiSwiGLU, pg8::StaticOrder, true, true>(lds, g, S, E); }
    GRID_SYNC();
    { pg8::Gemm g{BIG, W2D, M, D, FF, FF, 1 << 20, 0}; pg8::StaticOrder S; S.init(M, D, G, bx);
      pg8::EpiResF32 E{X, D, 0.5f};
      pg8::gemm_phase<pg8::EpiResF32, pg8::StaticOrder, true, true>(lds, g, S, E); }
    GRID_SYNC();
    {
        f32x4 g[4];
#pragma unroll
        for (int j = 0; j < 4; ++j) g[j] = ((const f32x4*)args.in[17])[lane + 64 * j];
        for (int m = gw; m < M; m += NGW) { f32x4 v[4]; rms_row(X + (size_t)m * D, g, v, lane); f32x4* xo = (f32x4*)(X + (size_t)m * D) + lane;
#pragma unroll
            for (int j = 0; j < 4; ++j) xo[64 * j] = v[j]; }
    }
}

extern "C" void kernel_launch(void* const* d_in, const int* in_sizes, int n_in, void* d_out, int out_size, void* d_ws, size_t ws_size, hipStream_t stream) {
    static int grid = 0;
    if (grid == 0) {
        if (n_in != 18 || in_sizes[0] != M * D || out_size != M * D || ws_size < WS_END) { fprintf(stderr, "kernel_launch: unexpected problem (n_in %d, in0 %d, out %d, ws %zu)\n", n_in, n_in > 0 ? in_sizes[0] : -1, out_size, ws_size); grid = -1; return; }
        int dev = 0, cus = 0, per_cu = 0;
        (void)hipGetDevice(&dev); (void)hipDeviceGetAttribute(&cus, hipDeviceAttributeMultiprocessorCount, dev);
        if (hipFuncSetAttribute((const void*)mk_fwd, hipFuncAttributeMaxDynamicSharedMemorySize, LDS_BYTES) != hipSuccess) { fprintf(stderr, "kernel_launch: hipFuncSetAttribute failed\n"); grid = -1; return; }
        if (hipOccupancyMaxActiveBlocksPerMultiprocessor(&per_cu, (const void*)mk_fwd, NWAVES * 64, LDS_BYTES) != hipSuccess || per_cu < 1) { fprintf(stderr, "kernel_launch: occupancy query gave %d\n", per_cu); per_cu = 1; (void)hipGetLastError(); }
        grid = cus * per_cu;
    }
    if (grid < 0) return;
    if (hipMemsetAsync(d_ws, 0, 16384, stream) != hipSuccess) { fprintf(stderr, "kernel_launch: memset failed\n"); return; }
    Args a{};
    for (int i = 0; i < 18; ++i) a.in[i] = (const float*)d_in[i];
    a.out = (float*)d_out; a.ws = (unsigned char*)d_ws; a.use_cg = 0; a.pad = 0;
    void* kargs[] = {&a};
    hipError_t e = hipLaunchCooperativeKernel((const void*)mk_fwd, dim3(grid), dim3(NWAVES * 64), kargs, LDS_BYTES, stream);
    if (e != hipSuccess) fprintf(stderr, "kernel_launch: cooperative launch failed: %s (grid %d)\n", hipGetErrorString(e), grid);
}
```

```cpp
#include <hip/hip_runtime.h>
#include <hip/hip_cooperative_groups.h>
#include <cstdio>
#include <cstdint>
#include <cmath>
namespace pg8 {
#define PG8_LAS __attribute__((address_space(3)))
typedef unsigned short bf16_t;
typedef short bf16x8 __attribute__((ext_vector_type(8)));
typedef float f32x4 __attribute__((ext_vector_type(4)));
typedef unsigned u32x4 __attribute__((ext_vector_type(4)));
constexpr int BM = 256, BK = 64, HALF = 128, HTB = HALF * BK * 2  , STAGE_BYTES = 8 * HTB, NXCD = 8, WGM = 8;

__host__ __device__ __forceinline__ int lds_byte(int r, int c) { const int st = (r >> 4) * 2 + (c >> 5), rr = r & 15, cc = c & 31, ob = rr * 64 + cc * 2; return st * 1024 + (ob ^ (((ob >> 9) & 1) << 5)); }
__host__ __device__ __forceinline__ void stage_rc(int b, int& R, int& C) { const int st = b / 1024, sb = b % 1024, swz = sb ^ (((sb >> 9) & 1) << 5); R = (st >> 1) * 16 + swz / 64; C = (st & 1) * 32 + (swz % 64) / 2; }
__host__ __device__ __forceinline__ int perm32(int rho) { const int n = rho >> 4, i = rho & 15; return 8 * (i >> 2) + 4 * n + (i & 3); }

struct Unit { int pm, pn; };
struct Gemm { const bf16_t* A; const bf16_t* Bt; int M, N, K, lda, grp_tiles, grp_cols; };

struct StaticOrder {
    int nM, nN, nwg, G, c;
    __host__ __device__ void init(int M, int N, int G_, int c_) { nM = M / BM; nN = N / BM; nwg = nM * nN; G = G_; c = c_; }
    __host__ __device__ bool next(int i, Unit& u) const {
        const long L = (long)i * G + c; if (L >= nwg) return false;
        int wgid = (int)L; { const int q = nwg / NXCD, r = nwg % NXCD, xcd = wgid % NXCD, off = wgid / NXCD; wgid = (xcd < r ? xcd * (q + 1) : r * (q + 1) + (xcd - r) * q) + off; }
        const int nig = WGM * nN, gid = wgid / nig, fm = gid * WGM, gsz = (nM - fm) < WGM ? (nM - fm) : WGM;
        u.pm = fm + ((wgid % nig) % gsz); u.pn = (wgid % nig) / gsz; return true;
    }
    __device__ __forceinline__ void a_ready(const Unit&) const {}
    __device__ __forceinline__ void done(const Unit&) const {}
};

typedef float f32x2_t __attribute__((ext_vector_type(2))); typedef __bf16 bf16x2_t __attribute__((ext_vector_type(2)));
__device__ __forceinline__ unsigned cvt_pk_bf16(float lo, float hi) { f32x2_t v = {lo, hi}; bf16x2_t b = __builtin_convertvector(v, bf16x2_t); return __builtin_bit_cast(unsigned, b); }
constexpr float LOG2E = 1.4426950408889634f;
__device__ __forceinline__ float sigmoid_f(float v) { return __builtin_amdgcn_rcpf(1.0f + __builtin_amdgcn_exp2f(-v * LOG2E)); }
__device__ __forceinline__ u32x4 pack8(const f32x4 a, const f32x4 b) { u32x4 w; w.x = cvt_pk_bf16(a[0], a[1]); w.y = cvt_pk_bf16(a[2], a[3]); w.z = cvt_pk_bf16(b[0], b[1]); w.w = cvt_pk_bf16(b[2], b[3]); return w; }

struct EpiSwiGLU {
    static constexpr bool PERM = true, AFTER_DRAIN = false;
    bf16_t* O; int ldc;
    __device__ __forceinline__ void operator()(const f32x4 (&acc)[2][2][4][2], const Unit& u, int wr, int wc, int fr, int fq) const {
        const int row0 = u.pm * BM + wr * 64 + fr, col0 = u.pn * HALF + wc * 32 + 8 * fq;
#pragma unroll
        for (int ai = 0; ai < 2; ++ai)
#pragma unroll
            for (int m = 0; m < 4; ++m) { bf16_t* rowp = O + (size_t)(row0 + ai * HALF + m * 16) * ldc + col0;
                f32x4 v[2];
#pragma unroll
                for (int n = 0; n < 2; ++n) { const f32x4 g = acc[ai][0][m][n], up = acc[ai][1][m][n];
#pragma unroll
                    for (int e = 0; e < 4; ++e) v[n][e] = g[e] * sigmoid_f(g[e]) * up[e]; }
                *(u32x4*)rowp = pack8(v[0], v[1]); }
    }
};
struct EpiResF32 {
    static constexpr bool PERM = false, AFTER_DRAIN = false;
    const float* R; float* X; int ldc; float scale;
    __device__ __forceinline__ void operator()(const f32x4 (&acc)[2][2][4][2], const Unit& u, int wr, int wc, int fr, int fq) const {
        const int row0 = u.pm * BM + wr * 64 + fr, col0 = u.pn * BM + wc * 32 + 4 * fq;
#pragma unroll
        for (int ai = 0; ai < 2; ++ai)
#pragma unroll
            for (int m = 0; m < 4; ++m) { const size_t off = (size_t)(row0 + ai * HALF + m * 16) * ldc + col0;
#pragma unroll
                for (int bj = 0; bj < 2; ++bj)
#pragma unroll
                    for (int n = 0; n < 2; ++n) { const f32x4 r = *(const f32x4*)(R + off + bj * HALF + n * 16); *(f32x4*)(X + off + bj * HALF + n * 16) = r + acc[ai][bj][m][n] * scale; } }
    }
};
struct EpiQKVG {
    static constexpr bool PERM = true, AFTER_DRAIN = false;
    bf16_t* QKV; bf16_t* G; const float* bgate; float c2;
    __device__ __forceinline__ void operator()(const f32x4 (&acc)[2][2][4][2], const Unit& u, int wr, int wc, int fr, int fq) const {
        const int row0 = u.pm * BM + wr * 64 + fr;
        if (u.pn < 12) {
            const float sc = (u.pn < 2 || (u.pn >= 6 && u.pn < 8)) ? c2 : 1.0f;
            const int col0 = u.pn * BM + wc * 32 + 8 * fq;
#pragma unroll
            for (int ai = 0; ai < 2; ++ai)
#pragma unroll
                for (int m = 0; m < 4; ++m) { bf16_t* rowp = QKV + (size_t)(row0 + ai * HALF + m * 16) * 3072 + col0;
#pragma unroll
                    for (int bj = 0; bj < 2; ++bj) *(u32x4*)(rowp + bj * HALF) = pack8(acc[ai][bj][m][0] * sc, acc[ai][bj][m][1] * sc); }
        } else {
            const int col0 = (u.pn - 12) * BM + wc * 32 + 8 * fq;
            f32x4 bv[2][2];
#pragma unroll
            for (int bj = 0; bj < 2; ++bj)
#pragma unroll
                for (int n = 0; n < 2; ++n) bv[bj][n] = *(const f32x4*)(bgate + col0 + bj * HALF + 4 * n);
#pragma unroll
            for (int ai = 0; ai < 2; ++ai)
#pragma unroll
                for (int m = 0; m < 4; ++m) { bf16_t* rowp = G + (size_t)(row0 + ai * HALF + m * 16) * 2048 + col0;
#pragma unroll
                    for (int bj = 0; bj < 2; ++bj) { f32x4 v[2];
#pragma unroll
                        for (int n = 0; n < 2; ++n) { const f32x4 t = acc[ai][bj][m][n] + bv[bj][n];
#pragma unroll
                            for (int e = 0; e < 4; ++e) v[n][e] = sigmoid_f(t[e]); }
                        *(u32x4*)(rowp + bj * HALF) = pack8(v[0], v[1]); } }
        }
    }
};
struct EpiGateMul {
    static constexpr bool PERM = true, AFTER_DRAIN = false;
    bf16_t* U; const bf16_t* G; int ldc;
    __device__ __forceinline__ void operator()(const f32x4 (&acc)[2][2][4][2], const Unit& u, int wr, int wc, int fr, int fq) const {
        const int row0 = u.pm * BM + wr * 64 + fr, col0 = u.pn * BM + wc * 32 + 8 * fq;
#pragma unroll
        for (int ai = 0; ai < 2; ++ai)
#pragma unroll
            for (int m = 0; m < 4; ++m) { const size_t off = (size_t)(row0 + ai * HALF + m * 16) * ldc + col0;
#pragma unroll
                for (int bj = 0; bj < 2; ++bj) { const u32x4 gw = *(const u32x4*)(G + off + bj * HALF);
                    f32x4 g0, g1;
                    g0[0] = __uint_as_float(gw.x << 16); g0[1] = __uint_as_float(gw.x & 0xffff0000u); g0[2] = __uint_as_float(gw.y << 16); g0[3] = __uint_as_float(gw.y & 0xffff0000u);
                    g1[0] = __uint_as_float(gw.z << 16); g1[1] = __uint_as_float(gw.z & 0xffff0000u); g1[2] = __uint_as_float(gw.w << 16); g1[3] = __uint_as_float(gw.w & 0xffff0000u);
                    *(u32x4*)(U + off + bj * HALF) = pack8(acc[ai][bj][m][0] * g0, acc[ai][bj][m][1] * g1); } }
    }
};

template <class Epi, class Sched, bool ALIGN_EPI = false, bool SP2 = false>
__device__ __forceinline__ void gemm_phase(PG8_LAS unsigned char* lds, const Gemm g, const Sched& S, const Epi& E) {
    int tid_ = threadIdx.x; asm volatile("" : "+v"(tid_));
    const int tid = tid_, wid = __builtin_amdgcn_readfirstlane(tid >> 6), lane = tid & 63, wr = wid >> 2, wc = wid & 3, fr = lane & 15, fq = lane >> 4;
    const int K = g.K, nt = K / BK;
    unsigned voffA[2], voffB[2];
#pragma unroll
    for (int i = 0; i < 2; ++i) { int R, C; stage_rc(tid * 16 + i * 8192, R, C); const int Rb = Epi::PERM ? ((R & ~31) + perm32(R & 31)) : R;
        voffA[i] = (unsigned)(R * g.lda + C) * 2u; voffB[i] = (unsigned)(Rb * K + C) * 2u; }
    const size_t kstep = (size_t)(BK * 2);
    const size_t hstepA = (size_t)HALF * g.lda * 2, hstepB = (size_t)HALF * K * 2;
    const size_t tstepA = 2 * hstepA, tstepB = 2 * hstepB;
    const unsigned ldsw = (unsigned)wid * 1024u;
    const int aoff = lds_byte(wr * 64 + fr, fq * 8), boff = lds_byte(wc * 32 + fr, fq * 8);
#define PG8_SA(b, h) (((b) * 2 + (h)) * HTB)
#define PG8_SB(b, h) ((4 + (b) * 2 + (h)) * HTB)
#define PG8_STAGE(bufoff, gbase, voff) do { _Pragma("unroll") for (int _i = 0; _i < 2; ++_i) \
        __builtin_amdgcn_global_load_lds((const unsigned*)((const char*)(gbase) + (voff)[_i]), (PG8_LAS unsigned*)(lds + (bufoff) + ldsw + _i * 8192), 16, 0, 0); } while (0)
#define PG8_LDA(dst, b, h) do { _Pragma("unroll") for (int m = 0; m < 4; ++m) _Pragma("unroll") for (int k = 0; k < 2; ++k) dst[m][k] = *(const PG8_LAS bf16x8*)(lds + PG8_SA(b, h) + aoff + m * 2048 + k * 1024); } while (0)
#define PG8_LDB(dst, b, h) do { _Pragma("unroll") for (int n = 0; n < 2; ++n) _Pragma("unroll") for (int k = 0; k < 2; ++k) dst[n][k] = *(const PG8_LAS bf16x8*)(lds + PG8_SB(b, h) + boff + n * 2048 + k * 1024); } while (0)
#define PG8_MMA(ai, bj, At, Bt) do { __builtin_amdgcn_s_setprio(1); _Pragma("unroll") for (int m = 0; m < 4; ++m) _Pragma("unroll") for (int n = 0; n < 2; ++n) _Pragma("unroll") for (int k = 0; k < 2; ++k) \
        acc[ai][bj][m][n] = __builtin_amdgcn_mfma_f32_16x16x32_bf16(Bt[n][k], At[m][k], acc[ai][bj][m][n], 0, 0, 0); __builtin_amdgcn_s_setprio(0); } while (0)
#define PG8_WAIT_V(n) asm volatile("s_waitcnt vmcnt(" #n ")" ::: "memory")
#define PG8_WAIT_L(n) asm volatile("s_waitcnt lgkmcnt(" #n ")" ::: "memory")
#define PG8_BAR __builtin_amdgcn_s_barrier()
#define PG8_SCHED __builtin_amdgcn_sched_barrier(0)
    Unit cur, nxt; int ui = 0;
    if (!S.next(0, cur)) return;
    f32x4 acc[2][2][4][2];
#pragma unroll
    for (int a = 0; a < 2; ++a)
#pragma unroll
        for (int b = 0; b < 2; ++b)
#pragma unroll
            for (int m = 0; m < 4; ++m)
#pragma unroll
                for (int n = 0; n < 2; ++n) acc[a][b][m][n] = (f32x4){0.f, 0.f, 0.f, 0.f};
    bf16x8 At[4][2], B0[2][2], B1[2][2];
    const char* cA = (const char*)g.A + (size_t)cur.pm * tstepA + (size_t)((cur.pn / g.grp_tiles) * g.grp_cols) * 2; const char* cB = (const char*)g.Bt + (size_t)cur.pn * tstepB;
    S.a_ready(cur);
    if constexpr (SP2) {
        PG8_STAGE(PG8_SB(0, 0), cB, voffB); PG8_STAGE(PG8_SB(0, 1), cB + hstepB, voffB); PG8_STAGE(PG8_SA(0, 0), cA, voffA); PG8_STAGE(PG8_SA(0, 1), cA + hstepA, voffA);
        if (wr == 1) PG8_BAR;
        PG8_WAIT_V(2); PG8_BAR;
        PG8_STAGE(PG8_SB(1, 0), cB + kstep, voffB); PG8_STAGE(PG8_SA(1, 0), cA + kstep, voffA); PG8_STAGE(PG8_SB(1, 1), cB + hstepB + kstep, voffB);
        PG8_WAIT_V(6); PG8_BAR;
    } else {
        PG8_STAGE(PG8_SB(0, 0), cB, voffB); PG8_STAGE(PG8_SA(0, 0), cA, voffA); PG8_STAGE(PG8_SB(0, 1), cB + hstepB, voffB); PG8_STAGE(PG8_SA(0, 1), cA + hstepA, voffA);
        if (wr == 1) PG8_BAR;
        PG8_WAIT_V(4); PG8_BAR;
        PG8_STAGE(PG8_SB(1, 0), cB + kstep, voffB); PG8_STAGE(PG8_SA(1, 0), cA + kstep, voffA); PG8_STAGE(PG8_SB(1, 1), cB + hstepB + kstep, voffB);
        PG8_WAIT_V(6); PG8_BAR;
    }
    for (;;) {
        const bool has_next = S.next(ui + 1, nxt);
        const char* nA = has_next ? (const char*)g.A + (size_t)nxt.pm * tstepA + (size_t)((nxt.pn / g.grp_tiles) * g.grp_cols) * 2 : cA; const char* nB = has_next ? (const char*)g.Bt + (size_t)nxt.pn * tstepB : cB;
        for (int t = 0; t < nt; t += 2) {
            const bool last = (t == nt - 2);
            const char* a1 = cA + (size_t)(t + 1) * kstep;
            const char* a2 = last ? nA : cA + (size_t)(t + 2) * kstep; const char* b2 = last ? nB : cB + (size_t)(t + 2) * kstep;
            const char* a3 = a2 + kstep; const char* b3 = b2 + kstep;
            if (last && has_next) S.a_ready(nxt);
            if constexpr (SP2) {
            PG8_LDB(B0, 0, 0); PG8_LDB(B1, 0, 1); PG8_SCHED; PG8_LDA(At, 0, 0); PG8_STAGE(PG8_SA(1, 1), a1 + hstepA, voffA);
            PG8_WAIT_V(8); PG8_WAIT_L(0); PG8_BAR; PG8_MMA(0, 0, At, B0); PG8_MMA(0, 1, At, B1); PG8_BAR; PG8_SCHED;
            PG8_LDA(At, 0, 1); PG8_STAGE(PG8_SB(0, 0), b2, voffB); PG8_STAGE(PG8_SB(0, 1), b2 + hstepB, voffB); PG8_STAGE(PG8_SA(0, 0), a2, voffA);
            PG8_WAIT_V(8); PG8_WAIT_L(0); PG8_BAR; PG8_MMA(1, 0, At, B0); PG8_MMA(1, 1, At, B1); PG8_BAR; PG8_SCHED;
            PG8_LDB(B0, 1, 0); PG8_LDB(B1, 1, 1); PG8_SCHED; PG8_LDA(At, 1, 0); PG8_STAGE(PG8_SA(0, 1), a2 + hstepA, voffA);
            PG8_WAIT_V(8); PG8_WAIT_L(0); PG8_BAR; PG8_MMA(0, 0, At, B0); PG8_MMA(0, 1, At, B1); PG8_BAR; PG8_SCHED;
            PG8_LDA(At, 1, 1); PG8_STAGE(PG8_SB(1, 0), b3, voffB); PG8_STAGE(PG8_SB(1, 1), b3 + hstepB, voffB); PG8_STAGE(PG8_SA(1, 0), a3, voffA);
            PG8_WAIT_V(8); PG8_WAIT_L(0); PG8_BAR; PG8_MMA(1, 0, At, B0); PG8_MMA(1, 1, At, B1); PG8_BAR; PG8_SCHED;
            } else {
            PG8_LDB(B0, 0, 0); PG8_SCHED; PG8_LDA(At, 0, 0); PG8_STAGE(PG8_SA(1, 1), a1 + hstepA, voffA);
            PG8_WAIT_L(8); PG8_BAR; PG8_WAIT_L(0); PG8_MMA(0, 0, At, B0); PG8_BAR; PG8_SCHED;
            PG8_LDB(B1, 0, 1); PG8_STAGE(PG8_SB(0, 0), b2, voffB);
            PG8_BAR; PG8_WAIT_L(0); PG8_MMA(0, 1, At, B1); PG8_BAR;
            PG8_LDA(At, 0, 1); PG8_STAGE(PG8_SA(0, 0), a2, voffA);
            PG8_BAR; PG8_WAIT_L(0); PG8_MMA(1, 0, At, B0); PG8_BAR; PG8_SCHED;
            PG8_STAGE(PG8_SB(0, 1), b2 + hstepB, voffB);
            PG8_WAIT_V(6); PG8_BAR; PG8_MMA(1, 1, At, B1); PG8_BAR;
            PG8_LDB(B0, 1, 0); PG8_SCHED; PG8_LDA(At, 1, 0); PG8_STAGE(PG8_SA(0, 1), a2 + hstepA, voffA);
            PG8_WAIT_L(8); PG8_BAR; PG8_WAIT_L(0); PG8_MMA(0, 0, At, B0); PG8_BAR; PG8_SCHED;
            PG8_LDB(B1, 1, 1); PG8_STAGE(PG8_SB(1, 0), b3, voffB);
            PG8_BAR; PG8_WAIT_L(0); PG8_MMA(0, 1, At, B1); PG8_BAR;
            PG8_LDA(At, 1, 1); PG8_STAGE(PG8_SA(1, 0), a3, voffA);
            PG8_BAR; PG8_WAIT_L(0); PG8_MMA(1, 0, At, B0); PG8_BAR; PG8_SCHED;
            PG8_STAGE(PG8_SB(1, 1), b3 + hstepB, voffB);
            PG8_WAIT_V(6); PG8_BAR; PG8_MMA(1, 1, At, B1); PG8_BAR;
            }
        }
        if constexpr (ALIGN_EPI) { if (wr == 0) PG8_BAR; }
        if constexpr (!Epi::AFTER_DRAIN) { E(acc, cur, wr, wc, fr, fq); S.done(cur); }
        if (!has_next) break;
#pragma unroll
        for (int a = 0; a < 2; ++a)
#pragma unroll
            for (int b = 0; b < 2; ++b)
#pragma unroll
                for (int m = 0; m < 4; ++m)
#pragma unroll
                    for (int n = 0; n < 2; ++n) acc[a][b][m][n] = (f32x4){0.f, 0.f, 0.f, 0.f};
        cur = nxt; cA = nA; cB = nB; ++ui;
        if constexpr (ALIGN_EPI) { if (wr == 1) PG8_BAR; }
    }
    PG8_WAIT_V(0);
    if constexpr (!ALIGN_EPI) { if (wr == 0) PG8_BAR; }
    PG8_BAR;
    if constexpr (Epi::AFTER_DRAIN) { E.fused(acc, cur, wr, wc, fr, fq, lds, wid, lane); S.done(cur); }
#undef PG8_SA
#undef PG8_SB
#undef PG8_STAGE
#undef PG8_LDA
#undef PG8_LDB
#undef PG8_MMA
#undef PG8_WAIT_V
#undef PG8_WAIT_L
#undef PG8_BAR
#undef PG8_SCHED
}
}
namespace att {
#define ALAS __attribute__((address_space(3)))
typedef unsigned short bf16_t;
typedef short bf16x8 __attribute__((ext_vector_type(8)));
typedef short s16x4 __attribute__((ext_vector_type(4)));
typedef float f32x16 __attribute__((ext_vector_type(16)));
typedef float f32x4 __attribute__((ext_vector_type(4)));
typedef unsigned u32x4 __attribute__((ext_vector_type(4)));
typedef unsigned u32x2 __attribute__((ext_vector_type(2)));
constexpr int SEQ = 2048, QP = 3072, YP = 1024;
constexpr int KBUF = 0, VBUF = 16384, LFC_OFF = 32768, RED_OFF = 40960, ATT_LDS = 41216;
typedef float f32x2_t __attribute__((ext_vector_type(2))); typedef __bf16 bf16x2_t __attribute__((ext_vector_type(2)));
__device__ __forceinline__ unsigned cvtpk(float lo, float hi) { f32x2_t v = {lo, hi}; bf16x2_t b = __builtin_convertvector(v, bf16x2_t); return __builtin_bit_cast(unsigned, b); }
__device__ __forceinline__ s16x4 vtr(const ALAS unsigned char* p) { return __builtin_bit_cast(s16x4, __builtin_amdgcn_ds_read_tr16_b64_v4i16((ALAS s16x4*)p)); }
__device__ __forceinline__ float halfswap_max(float v) { auto rr = __builtin_amdgcn_permlane32_swap(__float_as_uint(v), __float_as_uint(v), false, false); return fmaxf(__uint_as_float(rr[0]), __uint_as_float(rr[1])); }
__device__ __forceinline__ float halfswap_sum(float v) { auto rr = __builtin_amdgcn_permlane32_swap(__float_as_uint(v), __float_as_uint(v), false, false); return __uint_as_float(rr[0]) + __uint_as_float(rr[1]); }

template <int MODE>
__device__ __forceinline__ void attn_unit(int b, int h, int qb, const bf16_t* __restrict__ QKV, bf16_t* __restrict__ Y, ALAS unsigned char* lds) {
    int tid_ = threadIdx.x; asm volatile("" : "+v"(tid_));
    const int tid = tid_, lane = tid & 63, r32 = lane & 31, hi = lane >> 5, wid = __builtin_amdgcn_readfirstlane(tid >> 6);
    const int q0 = qb * 256, qw = q0 + 32 * wid, q = qw + r32;
    const size_t rowbase = (size_t)b * SEQ;
    const int colq = (MODE ? 1536 : 0) + h * 64, colk = colq + 512, colv = colq + 1024;
    bf16x8 qr[4];
    { const bf16_t* Qp = QKV + (rowbase + q) * QP + colq + hi * 8;
#pragma unroll
      for (int d0 = 0; d0 < 4; ++d0) qr[d0] = *(const bf16x8*)(Qp + d0 * 16); }
    const bf16_t* ksrc = QKV + (rowbase + lane) * QP + colk + wid * 8;
    const bf16_t* vsrc = QKV + (rowbase + 16 * (wid & 3) + (lane >> 2)) * QP + colv + (wid >> 2) * 32 + (lane & 3) * 8;
    const int sto = wid * 1024 + lane * 16;
    const int NT = (q0 + 256) / 64;
    const int koff = hi * 1024 + r32 * 16;
    const int voff = ((lane >> 4) & 1) * 32 + (lane & 3) * 8 + (4 * hi + ((lane & 15) >> 2)) * 64;
    f32x16 o0, o1;
#pragma unroll
    for (int r = 0; r < 16; ++r) { o0[r] = 0.f; o1[r] = 0.f; }
    float m_run = -1e30f, l_run = 0.f, carry = 0.f;
    bool dead = false;
    ALAS int* dflag = (ALAS int*)(lds + RED_OFF + 64);
    { const int t0 = MODE ? 0 : NT - 1;
      const u32x4 kr = *(const u32x4*)(ksrc + (size_t)t0 * 64 * QP), vr = *(const u32x4*)(vsrc + (size_t)t0 * 64 * QP);
      *(ALAS u32x4*)(lds + KBUF + sto) = kr; *(ALAS u32x4*)(lds + VBUF + sto) = vr; }
    __syncthreads();
    for (int i = 0; i < NT; ++i) {
        const int t = MODE ? i : NT - 1 - i, tn = MODE ? t + 1 : t - 1;
        const bool more = (i + 1 < NT);
        u32x4 kr = {0u, 0u, 0u, 0u}, vr = {0u, 0u, 0u, 0u};
        if (more) { kr = *(const u32x4*)(ksrc + (size_t)tn * 64 * QP); vr = *(const u32x4*)(vsrc + (size_t)tn * 64 * QP); }
        const int bo = (i & 1) * 8192;
        if (64 * t <= qw + 31 && !dead) {
            f32x16 p0, p1;
#pragma unroll
            for (int r = 0; r < 16; ++r) { p0[r] = 0.f; p1[r] = 0.f; }
#pragma unroll
            for (int d0 = 0; d0 < 4; ++d0) {
                const bf16x8 k0 = *(const ALAS bf16x8*)(lds + KBUF + bo + koff + d0 * 2048);
                const bf16x8 k1 = *(const ALAS bf16x8*)(lds + KBUF + bo + koff + d0 * 2048 + 512);
                p0 = __builtin_amdgcn_mfma_f32_32x32x16_bf16(k0, qr[d0], p0, 0, 0, 0);
                p1 = __builtin_amdgcn_mfma_f32_32x32x16_bf16(k1, qr[d0], p1, 0, 0, 0);
            }
            const int kv0 = 64 * t + 4 * hi;
            const bool diag = (64 * t + 63 >= qw);
            if (MODE == 1) {
#pragma unroll
                for (int g4 = 0; g4 < 4; ++g4) {
                    const f32x4 b0 = *(const ALAS f32x4*)(lds + LFC_OFF + (kv0 + 8 * g4) * 4), b1 = *(const ALAS f32x4*)(lds + LFC_OFF + (kv0 + 32 + 8 * g4) * 4);
#pragma unroll
                    for (int e = 0; e < 4; ++e) { p0[4 * g4 + e] += b0[e]; p1[4 * g4 + e] += b1[e]; }
                }
                if (diag) {
#pragma unroll
                    for (int r = 0; r < 16; ++r) { const int kv = kv0 + (r & 3) + 8 * (r >> 2); if (kv > q) p0[r] = -INFINITY; if (kv + 32 > q) p1[r] = -INFINITY; }
                }
                float mx = fmaxf(p0[0], p1[0]);
#pragma unroll
                for (int r = 1; r < 16; ++r) mx = fmaxf(mx, fmaxf(p0[r], p1[r]));
                mx = halfswap_max(mx);
                const float m_new = fmaxf(m_run, mx), f = __builtin_amdgcn_exp2f(m_run - m_new);
                m_run = m_new;
                float rs = 0.f;
#pragma unroll
                for (int r = 0; r < 16; ++r) { p0[r] = __builtin_amdgcn_exp2f(p0[r] - m_new); p1[r] = __builtin_amdgcn_exp2f(p1[r] - m_new); rs += p0[r] + p1[r]; }
                l_run = l_run * f + rs;
#pragma unroll
                for (int r = 0; r < 16; ++r) { o0[r] *= f; o1[r] *= f; }
            } else {
                f32x16 n0, n1;
#pragma unroll
                for (int r = 0; r < 16; ++r) {
                    { const float z = p0[r], lab = __builtin_amdgcn_logf(1.0f + __builtin_amdgcn_exp2f(-fabsf(z))), L = fminf(z, 0.f) - lab; p0[r] = L; n0[r] = L - z; }
                    { const float z = p1[r], lab = __builtin_amdgcn_logf(1.0f + __builtin_amdgcn_exp2f(-fabsf(z))), L = fminf(z, 0.f) - lab; p1[r] = L; n1[r] = L - z; }
                }
                if (diag) {
#pragma unroll
                    for (int r = 0; r < 16; ++r) { const int kv = kv0 + (r & 3) + 8 * (r >> 2);
                        if (kv >= q) { p0[r] = -INFINITY; n0[r] = 0.f; } if (kv + 32 >= q) { p1[r] = -INFINITY; n1[r] = 0.f; } }
                }
                float T[8], X[8];
#pragma unroll
                for (int k = 0; k < 8; ++k) {
                    const float gsum = (k < 4) ? ((n0[4 * k] + n0[4 * k + 1]) + (n0[4 * k + 2] + n0[4 * k + 3])) : ((n1[4 * (k - 4)] + n1[4 * (k - 4) + 1]) + (n1[4 * (k - 4) + 2] + n1[4 * (k - 4) + 3]));
                    auto rr = __builtin_amdgcn_permlane32_swap(__float_as_uint(gsum), __float_as_uint(gsum), false, false);
                    const float vlo = __uint_as_float(rr[0]), vhi = __uint_as_float(rr[1]);
                    T[k] = vlo + vhi; X[k] = hi ? 0.f : vhi;
                }
                float suf = carry;
#pragma unroll
                for (int k = 7; k >= 0; --k) {
                    const float base = suf + X[k];
                    if (k < 4) { const int r = 4 * k; const float b3 = base, b2 = b3 + n0[r + 3], b1 = b2 + n0[r + 2], b0 = b1 + n0[r + 1];
                        p0[r] = __builtin_amdgcn_exp2f(p0[r] + b0); p0[r + 1] = __builtin_amdgcn_exp2f(p0[r + 1] + b1); p0[r + 2] = __builtin_amdgcn_exp2f(p0[r + 2] + b2); p0[r + 3] = __builtin_amdgcn_exp2f(p0[r + 3] + b3); }
                    else { const int r = 4 * (k - 4); const float b3 = base, b2 = b3 + n1[r + 3], b1 = b2 + n1[r + 2], b0 = b1 + n1[r + 1];
                        p1[r] = __builtin_amdgcn_exp2f(p1[r] + b0); p1[r + 1] = __builtin_amdgcn_exp2f(p1[r + 1] + b1); p1[r + 2] = __builtin_amdgcn_exp2f(p1[r + 2] + b2); p1[r + 3] = __builtin_amdgcn_exp2f(p1[r + 3] + b3); }
                    suf += T[k];
                }
                carry = suf;
                dead = __all(carry < -152.0f) != 0;
            }
            bf16x8 pw[4];
#pragma unroll
            for (int ks = 0; ks < 4; ++ks) { const int r = 8 * (ks & 1); u32x4 w;
                if (ks < 2) { w.x = cvtpk(p0[r], p0[r + 1]); w.y = cvtpk(p0[r + 2], p0[r + 3]); w.z = cvtpk(p0[r + 4], p0[r + 5]); w.w = cvtpk(p0[r + 6], p0[r + 7]); }
                else        { w.x = cvtpk(p1[r], p1[r + 1]); w.y = cvtpk(p1[r + 2], p1[r + 3]); w.z = cvtpk(p1[r + 4], p1[r + 5]); w.w = cvtpk(p1[r + 6], p1[r + 7]); }
                pw[ks] = __builtin_bit_cast(bf16x8, w); }
#pragma unroll
            for (int ks = 0; ks < 4; ++ks) {
                const ALAS unsigned char* vp = lds + VBUF + bo + voff + ks * 1024;
                const s16x4 a0 = vtr(vp), a1 = vtr(vp + 512), c0 = vtr(vp + 4096), c1 = vtr(vp + 4096 + 512);
                const bf16x8 vf0 = {a0[0], a0[1], a0[2], a0[3], a1[0], a1[1], a1[2], a1[3]}, vf1 = {c0[0], c0[1], c0[2], c0[3], c1[0], c1[1], c1[2], c1[3]};
                o0 = __builtin_amdgcn_mfma_f32_32x32x16_bf16(vf0, pw[ks], o0, 0, 0, 0);
                o1 = __builtin_amdgcn_mfma_f32_32x32x16_bf16(vf1, pw[ks], o1, 0, 0, 0);
            }
        }
        if (more) { const int bn = ((i + 1) & 1) * 8192; *(ALAS u32x4*)(lds + KBUF + bn + sto) = kr; *(ALAS u32x4*)(lds + VBUF + bn + sto) = vr; }
        if (MODE == 0 && lane == 0) dflag[(i & 1) * 8 + wid] = dead ? 1 : 0;
        __syncthreads();
        if (MODE == 0) {
            const ALAS int* fp = dflag + (i & 1) * 8;
            const int all = fp[0] & fp[1] & fp[2] & fp[3] & fp[4] & fp[5] & fp[6] & fp[7];
            if (all) { __syncthreads(); break; }
        }
    }
    float inv = 1.0f;
    if (MODE == 1) { const float lt = halfswap_sum(l_run); inv = 1.0f / lt; }
    bf16_t* Yp = Y + (rowbase + q) * YP + (MODE ? 512 : 0) + h * 64 + 4 * hi;
#pragma unroll
    for (int g4 = 0; g4 < 4; ++g4) {
        u32x2 w0, w1;
        w0.x = cvtpk(o0[4 * g4] * inv, o0[4 * g4 + 1] * inv); w0.y = cvtpk(o0[4 * g4 + 2] * inv, o0[4 * g4 + 3] * inv);
        w1.x = cvtpk(o1[4 * g4] * inv, o1[4 * g4 + 1] * inv); w1.y = cvtpk(o1[4 * g4 + 2] * inv, o1[4 * g4 + 3] * inv);
        *(u32x2*)(Yp + 8 * g4) = w0; *(u32x2*)(Yp + 32 + 8 * g4) = w1;
    }
}
__device__ __forceinline__ void fox_bias_scan(const float* __restrict__ LF, int bh, ALAS unsigned char* lds) {
    const int tid = threadIdx.x, lane = tid & 63, wid = tid >> 6;
    const f32x4 v = *(const f32x4*)(LF + (size_t)bh * SEQ + 4 * tid);
    const float s1 = v[0], s2 = s1 + v[1], s3 = s2 + v[2], s4 = s3 + v[3];
    float inc = s4;
#pragma unroll
    for (int o = 1; o < 64; o <<= 1) { const float up = __shfl_up(inc, o); if (lane >= o) inc += up; }
    ALAS float* red = (ALAS float*)(lds + RED_OFF);
    if (lane == 63) red[wid] = inc;
    __syncthreads();
    float woff = 0.f;
    for (int w = 0; w < wid; ++w) woff += red[w];
    const float ex = woff + inc - s4;
    const float c = -1.4426950408889634f;
    f32x4 o; o[0] = c * (ex + s1); o[1] = c * (ex + s2); o[2] = c * (ex + s3); o[3] = c * (ex + s4);
    *(ALAS f32x4*)(lds + LFC_OFF + 16 * tid) = o;
    __syncthreads();
}
}
namespace cg = cooperative_groups;
constexpr int NWAVES = 8;
constexpr int BATCH = 8, SEQ = 2048, D = 1024, FF = 2816, M = BATCH * SEQ, INC = 3080;
constexpr float RMS_EPS = 1e-6f;
constexpr float C2 = 0.125f * 1.4426950408889634f;
constexpr size_t MiB = 1u << 20;
constexpr size_t WS_LF = 1 * MiB;
constexpr size_t WS_W1GU = 2 * MiB, WS_W1D = 13 * MiB, WS_W2GU = 19 * MiB, WS_W2D = 30 * MiB, WS_WQKVG = 36 * MiB, WS_WUP = 46 * MiB, WS_WOUT = 48 * MiB;
constexpr size_t WS_XN = 52 * MiB;
constexpr size_t WS_BIG = 84 * MiB;
constexpr size_t WS_GATES = 180 * MiB;
constexpr size_t WS_END = 244 * MiB;
constexpr int LDS_BYTES = 147456;

typedef unsigned short bf16;
typedef unsigned v4u __attribute__((ext_vector_type(4)));
typedef float f32x4 __attribute__((ext_vector_type(4)));
#define LAS __attribute__((address_space(3)))
#define LDS_WAIT() asm volatile("s_waitcnt lgkmcnt(0)" ::: "memory")
__device__ __forceinline__ unsigned pk2(float lo, float hi) { return pg8::cvt_pk_bf16(lo, hi); }
__device__ __forceinline__ float wave_sum(float v) {
#pragma unroll
    for (int o = 1; o < 64; o <<= 1) v += __shfl_xor(v, o);
    return v;
}
__device__ __forceinline__ void transpose_item(const float* __restrict__ W, int ldw, int k0, int n0, bf16* __restrict__ WT, int ldt, int drow0, int dk0, LAS float* scr, int lane) {
#pragma unroll 8
    for (int i = 0; i < 32; ++i) { const int kk = 2 * i + (lane >> 5); scr[kk * 33 + (lane & 31)] = W[(size_t)(k0 + kk) * ldw + n0 + (lane & 31)]; }
    LDS_WAIT(); asm volatile("" ::: "memory");
    const int c = lane & 7;
#pragma unroll
    for (int j = 0; j < 4; ++j) { const int n = (lane >> 3) + 8 * j; const LAS float* s = scr + (8 * c) * 33 + n;
        v4u o; o.x = pk2(s[0 * 33], s[1 * 33]); o.y = pk2(s[2 * 33], s[3 * 33]); o.z = pk2(s[4 * 33], s[5 * 33]); o.w = pk2(s[6 * 33], s[7 * 33]);
        *(v4u*)(WT + (size_t)(drow0 + n) * ldt + dk0 + k0 + 8 * c) = o; }
    LDS_WAIT(); asm volatile("" ::: "memory");
}
#define XB_TMO      128
#define XB_XCNT(j)  (256  + 64 * (j))
#define XB_XSUB(j)  (1280 + 64 * (j))
#define XB_XGEN(j)  (2304 + 64 * (j))
#define XB_TOP      3328
#define XB_TOPGEN   3392
#define XCD_BAR_WORDS 3456
#define XB_SPIN_CAP (1u << 18)

__device__ __forceinline__ unsigned xb_ld(unsigned* p)              { return __hip_atomic_load(p, __ATOMIC_RELAXED, __HIP_MEMORY_SCOPE_AGENT); }
__device__ __forceinline__ unsigned xb_add(unsigned* p, unsigned v) { return __hip_atomic_fetch_add(p, v, __ATOMIC_RELAXED, __HIP_MEMORY_SCOPE_AGENT); }
__device__ __forceinline__ unsigned xb_xcc_id() { return (unsigned)__builtin_amdgcn_s_getreg((3 << 11) | 20) & 0xFu; }
#define XB_SPIN(cond, bar) do { unsigned _sp = 0; while (cond) { __builtin_amdgcn_s_sleep(1); \
    if ((++_sp & 255u) == 0u) { if (xb_ld(&(bar)[XB_TMO])) break; if (_sp > XB_SPIN_CAP) { atomicAdd(&(bar)[XB_TMO], 1u); break; } } } } while (0)

struct XcdBarrier {
    unsigned* bar; unsigned x;
    volatile LAS unsigned* st;
};

__device__ __forceinline__ XcdBarrier xcd_barrier_post(unsigned* bar, volatile LAS unsigned* st) {
    XcdBarrier b; b.bar = bar; b.x = xb_xcc_id(); b.st = st;
    if (threadIdx.x == 0) (void)xb_add(&bar[XB_XCNT(b.x)], 1u);
    return b;
}
__device__ __forceinline__ void xcd_barrier_complete(unsigned* bar, unsigned x, unsigned& nloc, unsigned& nx) {
    const unsigned G = gridDim.x * gridDim.y * gridDim.z;
    unsigned sum, cnt, mine, sp = 0u;
    for (;;) {
        sum = 0u; cnt = 0u; mine = 0u;
#pragma unroll
        for (unsigned j = 0; j < 16; ++j) { const unsigned c = xb_ld(&bar[XB_XCNT(j)]); sum += c; cnt += (c > 0u) ? 1u : 0u; mine = (j == x) ? c : mine; }
        if (sum == G) break;
        __builtin_amdgcn_s_sleep(1);
        if ((++sp & 255u) == 0u) { if (xb_ld(&bar[XB_TMO])) break; if (sp > XB_SPIN_CAP) { atomicAdd(&bar[XB_TMO], 1u); break; } }
    }
    nloc = mine > 0u ? mine : 1u; nx = cnt > 0u ? cnt : 1u;
}

__device__ __forceinline__ void xcd_barrier(const XcdBarrier& b) {
    asm volatile("s_waitcnt vmcnt(0)" ::: "memory");
    __syncthreads();
    if (threadIdx.x == 0) {
        unsigned* bar = b.bar;
        __builtin_amdgcn_s_waitcnt(0);
        unsigned nloc = b.st[0], nx = b.st[1];
        if (nloc == 0u) { xcd_barrier_complete(bar, b.x, nloc, nx); b.st[0] = nloc; b.st[1] = nx; }
        const unsigned old = xb_add(&bar[XB_XSUB(b.x)], 1u);
        const unsigned gen = old / nloc;
        if (old + 1u == (gen + 1u) * nloc) {
            __builtin_amdgcn_fence(__ATOMIC_RELEASE, "agent");
            asm volatile("s_waitcnt vmcnt(0)" ::: "memory");
            const unsigned og = xb_add(&bar[XB_TOP], 1u);
            const unsigned tg = og / nx;
            if (og + 1u == (tg + 1u) * nx) xb_add(&bar[XB_TOPGEN], 1u);
            else XB_SPIN(xb_ld(&bar[XB_TOPGEN]) == tg, bar);
            __builtin_amdgcn_fence(__ATOMIC_ACQUIRE, "agent");
            xb_add(&bar[XB_XGEN(b.x)], 1u);
            asm volatile("s_waitcnt vmcnt(0)" ::: "memory");
        } else {
            XB_SPIN(xb_ld(&bar[XB_XGEN(b.x)]) == gen, bar);
            __builtin_amdgcn_fence(__ATOMIC_ACQUIRE, "agent");
            asm volatile("s_waitcnt vmcnt(0)" ::: "memory");
        }
    }
    __syncthreads();
}

struct Args { const float* in[18]; float* out; unsigned char* ws; int use_cg, pad; };
struct WItem { const float* W; int ldw, ncols32, K; bf16* WT; int ldt, mode, dk0; };
__device__ __forceinline__ void conv_matrix(const float* W, int ldw, int ncols, int K, bf16* WT, int ldt, int mode, int rowadd, int dk0, int& it, int gw, int NGW, LAS float* scr, int lane) {
    const int nb32 = ncols / 32, nitems = (K / 64) * nb32;
    int first = it + ((gw - it) % NGW + NGW) % NGW;
    for (int g = first; g < it + nitems; g += NGW) {
        const int r = g - it, kb = r / nb32, nb = r % nb32, k0 = 64 * kb, n0 = 32 * nb;
        int drow0 = n0 + rowadd;
        if (mode == 1) drow0 = 256 * (n0 / 128) + (n0 % 128);
        else if (mode == 2) drow0 = 256 * (n0 / 128) + 128 + (n0 % 128);
        transpose_item(W, ldw, k0, n0, WT, ldt, drow0, dk0, scr, lane);
    }
    it += nitems;
}
__device__ __forceinline__ void rms_row(const float* xrow, const f32x4 (&g)[4], f32x4 (&v)[4], int lane) {
    const f32x4* xr = (const f32x4*)xrow + lane; float s2 = 0.f;
#pragma unroll
    for (int j = 0; j < 4; ++j) { v[j] = xr[64 * j]; s2 += (v[j].x * v[j].x + v[j].y * v[j].y) + (v[j].z * v[j].z + v[j].w * v[j].w); }
    const float rstd = 1.0f / sqrtf(wave_sum(s2) * (1.0f / D) + RMS_EPS);
#pragma unroll
    for (int j = 0; j < 4; ++j) v[j] = v[j] * rstd * g[j];
}
__device__ __forceinline__ void store_row_bf16(bf16* orow, const f32x4 (&v)[4], int lane) {
    unsigned long long* o8 = (unsigned long long*)orow + lane;
#pragma unroll
    for (int j = 0; j < 4; ++j) o8[64 * j] = (unsigned long long)pk2(v[j].x, v[j].y) | ((unsigned long long)pk2(v[j].z, v[j].w) << 32);
}
__device__ __forceinline__ void norm_phase_bf16(const float* X, const float* gain, bf16* XN, int gw, int NGW, int lane) {
    f32x4 g[4];
#pragma unroll
    for (int j = 0; j < 4; ++j) g[j] = ((const f32x4*)gain)[lane + 64 * j];
    for (int m = gw; m < M; m += NGW) { f32x4 v[4]; rms_row(X + (size_t)m * D, g, v, lane); store_row_bf16(XN + (size_t)m * D, v, lane); }
}

#define GRID_SYNC() xcd_barrier(bar)
__global__ void __launch_bounds__(NWAVES * 64, 2) mk_fwd(Args args) {
    extern __shared__ __attribute__((aligned(16))) unsigned char lds_raw[];
    LAS unsigned char* lds = (LAS unsigned char*)lds_raw;
    if (args.use_cg) { cg::grid_group grid = cg::this_grid(); grid.sync(); }
    const int tid = threadIdx.x, lane = tid & 63, wave = __builtin_amdgcn_readfirstlane(tid >> 6);
    const int G = gridDim.x, bx = blockIdx.x;
    const int vcu = (G % 8 == 0) ? (bx % 8) * (G / 8) + bx / 8 : bx;
    const int gw = vcu * NWAVES + wave, NGW = G * NWAVES;
    unsigned char* ws = args.ws;
    const float* x = args.in[0];
    float* X = args.out;
    bf16* W1GU = (bf16*)(ws + WS_W1GU); bf16* W1D = (bf16*)(ws + WS_W1D); bf16* W2GU = (bf16*)(ws + WS_W2GU); bf16* W2D = (bf16*)(ws + WS_W2D);
    bf16* WQKVG = (bf16*)(ws + WS_WQKVG); bf16* WUP = (bf16*)(ws + WS_WUP); bf16* WOUT = (bf16*)(ws + WS_WOUT);
    bf16* XN = (bf16*)(ws + WS_XN); bf16* BIG = (bf16*)(ws + WS_BIG); bf16* GATES = (bf16*)(ws + WS_GATES);
    float* LF = (float*)(ws + WS_LF);
    volatile LAS unsigned* misc = (volatile LAS unsigned*)(lds + 131072 + 1024);
    if (tid < 2) misc[tid] = 0u;
    __syncthreads();
    XcdBarrier bar = xcd_barrier_post((unsigned*)ws, misc);

    {
        LAS float* scr = (LAS float*)(lds + wave * 16384);
        int it = 0;
        conv_matrix(args.in[2], FF, FF, D, W1GU, D, 1, 0, 0, it, gw, NGW, scr, lane);
        conv_matrix(args.in[3], FF, FF, D, W1GU, D, 2, 0, 0, it, gw, NGW, scr, lane);
        conv_matrix(args.in[4], D, D, FF, W1D, FF, 0, 0, 0, it, gw, NGW, scr, lane);
        conv_matrix(args.in[14], FF, FF, D, W2GU, D, 1, 0, 0, it, gw, NGW, scr, lane);
        conv_matrix(args.in[15], FF, FF, D, W2GU, D, 2, 0, 0, it, gw, NGW, scr, lane);
        conv_matrix(args.in[16], D, D, FF, W2D, FF, 0, 0, 0, it, gw, NGW, scr, lane);
        conv_matrix(args.in[6], INC, 3072, D, WQKVG, D, 0, 0, 0, it, gw, NGW, scr, lane);
        conv_matrix(args.in[8], 2048, 2048, D, WQKVG, D, 0, 3072, 0, it, gw, NGW, scr, lane);
        conv_matrix(args.in[10], D, D, 512, WUP, 512, 0, 0, 0, it, gw, NGW, scr, lane);
        conv_matrix(args.in[11], D, D, 512, WUP, 512, 0, 1024, 0, it, gw, NGW, scr, lane);
        conv_matrix(args.in[12], D, D, D, WOUT, 2048, 0, 0, 0, it, gw, NGW, scr, lane);
        conv_matrix(args.in[12], D, D, D, WOUT, 2048, 0, 0, 1024, it, gw, NGW, scr, lane);
        f32x4 g[4];
#pragma unroll
        for (int j = 0; j < 4; ++j) g[j] = ((const f32x4*)args.in[1])[lane + 64 * j];
        for (int m = gw; m < M; m += NGW) {
            f32x4 v[4]; rms_row(x + (size_t)m * D, g, v, lane); store_row_bf16(XN + (size_t)m * D, v, lane);
        }
    }
    GRID_SYNC();
    { pg8::Gemm g{XN, W1GU, M, 2 * FF, D, D, 1 << 20, 0}; pg8::StaticOrder S; S.init(M, 2 * FF, G, bx);
      pg8::EpiSwiGLU E{BIG, FF};
      pg8::gemm_phase<pg8::EpiSwiGLU, pg8::StaticOrder, true, true>(lds, g, S, E); }
    GRID_SYNC();
    { pg8::Gemm g{BIG, W1D, M, D, FF, FF, 1 << 20, 0}; pg8::StaticOrder S; S.init(M, D, G, bx);
      pg8::EpiResF32 E{x, X, D, 0.5f};
      pg8::gemm_phase<pg8::EpiResF32, pg8::StaticOrder, true, true>(lds, g, S, E); }
    GRID_SYNC();
    {
        f32x4 g[4];
#pragma unroll
        for (int j = 0; j < 4; ++j) g[j] = ((const f32x4*)args.in[5])[lane + 64 * j];
        const float* w_in = args.in[6];
        f32x4 wf[4][4][2];
#pragma unroll
        for (int j = 0; j < 4; ++j)
#pragma unroll
            for (int e = 0; e < 4; ++e) { const float* p = w_in + (size_t)(256 * j + 4 * lane + e) * INC + 3072; wf[j][e][0] = *(const f32x4*)p; wf[j][e][1] = *(const f32x4*)(p + 4); }
        const float bfg = args.in[7][lane & 7];
        for (int m = gw; m < M; m += NGW) {
            f32x4 v[4]; rms_row(X + (size_t)m * D, g, v, lane); store_row_bf16(XN + (size_t)m * D, v, lane);
            f32x4 a0 = {0.f, 0.f, 0.f, 0.f}, a1 = {0.f, 0.f, 0.f, 0.f};
#pragma unroll
            for (int j = 0; j < 4; ++j)
#pragma unroll
                for (int e = 0; e < 4; ++e) { a0 += wf[j][e][0] * v[j][e]; a1 += wf[j][e][1] * v[j][e]; }
            float fl[8] = {a0[0], a0[1], a0[2], a0[3], a1[0], a1[1], a1[2], a1[3]};
#pragma unroll
            for (int c = 0; c < 8; ++c) fl[c] = wave_sum(fl[c]);
            float mine = fl[0];
#pragma unroll
            for (int c = 1; c < 8; ++c) mine = ((lane & 7) == c) ? fl[c] : mine;
            if (lane < 8) { const float t = mine + bfg; const float ls = fminf(t, 0.f) - log1pf(expf(-fabsf(t)));
                LF[(size_t)((m / SEQ) * 8 + lane) * SEQ + (m % SEQ)] = ls; }
        }
    }
    GRID_SYNC();
    { pg8::Gemm g{XN, WQKVG, M, 5120, D, D, 1 << 20, 0}; pg8::StaticOrder S; S.init(M, 5120, G, bx);
      pg8::EpiQKVG E{BIG, GATES, args.in[9], C2};
      pg8::gemm_phase<pg8::EpiQKVG, pg8::StaticOrder, true, true>(lds, g, S, E); }
    GRID_SYNC();
    for (int pi = vcu; pi < 256; pi += G) {
        const int bh = pi >> 2, s = pi & 3, b = bh >> 3, h = bh & 7;
        att::attn_unit<0>(b, h, 7 - s, BIG, XN, lds);
        att::attn_unit<0>(b, h, s, BIG, XN, lds);
        att::fox_bias_scan(LF, bh, lds);
        att::attn_unit<1>(b, h, 7 - s, BIG, XN, lds);
        att::attn_unit<1>(b, h, s, BIG, XN, lds);
    }
    GRID_SYNC();
    { pg8::Gemm g{XN, WUP, M, 2048, 512, 1024, 4, 512}; pg8::StaticOrder S; S.init(M, 2048, G, bx);
      pg8::EpiGateMul E{BIG, GATES, 2048};
      pg8::gemm_phase<pg8::EpiGateMul, pg8::StaticOrder, true, true>(lds, g, S, E); }
    GRID_SYNC();
    { pg8::Gemm g{BIG, WOUT, M, D, 2048, 2048, 1 << 20, 0}; pg8::StaticOrder S; S.init(M, D, G, bx);
      pg8::EpiResF32 E{X, X, D, 1.0f};
      pg8::gemm_phase<pg8::EpiResF32, pg8::StaticOrder, true, true>(lds, g, S, E); }
    GRID_SYNC();
    norm_phase_bf16(X, args.in[13], XN, gw, NGW, lane);
    GRID_SYNC();
    { pg8::Gemm g{XN, W2GU, M, 2 * FF, D, D, 1 << 20, 0}; pg8::StaticOrder S; S.init(M, 2 * FF, G, bx);
      pg8::EpiSwiGLU E{BIG, FF};
      pg8::gemm_phase<pg8::EpiSwiGLU, pg8::StaticOrder, true, true>(lds, g, S, E); }
    GRID_SYNC();
    { pg8::Gemm g{BIG, W2D, M, D, FF, FF, 1 << 20, 0}; pg8::StaticOrder S; S.init(M, D, G, bx);
      pg8::EpiResF32 E{X, X, D, 0.5f};
      pg8::gemm_phase<pg8::EpiResF32, pg8::StaticOrder, true, true>(lds, g, S, E); }
    GRID_SYNC();
    {
        f32x4 g[4];
#pragma unroll
        for (int j = 0; j < 4; ++j) g[j] = ((const f32x4*)args.in[17])[lane + 64 * j];
        for (int m = gw; m < M; m += NGW) { f32x4 v[4]; rms_row(X + (size_t)m * D, g, v, lane); f32x4* xo = (f32x4*)(X + (size_t)m * D) + lane;
#pragma unroll
            for (int j = 0; j < 4; ++j) xo[64 * j] = v[j]; }
    }
}

extern "C" void kernel_launch(void* const* d_in, const int* in_sizes, int n_in, void* d_out, int out_size, void* d_ws, size_t ws_size, hipStream_t stream) {
    static int grid = 0;
    if (grid == 0) {
        if (n_in != 18 || in_sizes[0] != M * D || out_size != M * D || ws_size < WS_END) { fprintf(stderr, "kernel_launch: unexpected problem (n_in %d, in0 %d, out %d, ws %zu)\n", n_in, n_in > 0 ? in_sizes[0] : -1, out_size, ws_size); grid = -1; return; }
        int dev = 0, cus = 0, per_cu = 0;
        (void)hipGetDevice(&dev); (void)hipDeviceGetAttribute(&cus, hipDeviceAttributeMultiprocessorCount, dev);
        if (hipFuncSetAttribute((const void*)mk_fwd, hipFuncAttributeMaxDynamicSharedMemorySize, LDS_BYTES) != hipSuccess) { fprintf(stderr, "kernel_launch: hipFuncSetAttribute failed\n"); grid = -1; return; }
        if (hipOccupancyMaxActiveBlocksPerMultiprocessor(&per_cu, (const void*)mk_fwd, NWAVES * 64, LDS_BYTES) != hipSuccess || per_cu < 1) { fprintf(stderr, "kernel_launch: occupancy query gave %d\n", per_cu); per_cu = 1; (void)hipGetLastError(); }
        grid = cus * per_cu;
    }
    if (grid < 0) return;
    if (hipMemsetAsync(d_ws, 0, 16384, stream) != hipSuccess) { fprintf(stderr, "kernel_launch: memset failed\n"); return; }
    Args a{};
    for (int i = 0; i < 18; ++i) a.in[i] = (const float*)d_in[i];
    a.out = (float*)d_out; a.ws = (unsigned char*)d_ws; a.use_cg = 0; a.pad = 0;
    void* kargs[] = {&a};
    hipError_t e = hipLaunchCooperativeKernel((const void*)mk_fwd, dim3(grid), dim3(NWAVES * 64), kargs, LDS_BYTES, stream);
    if (e != hipSuccess) fprintf(stderr, "kernel_launch: cooperative launch failed: %s (grid %d)\n", hipGetErrorString(e), grid);
}
```
